# Optimizing an MI355X kernel written in HIP

```python
import jax
import jax.numpy as jnp
from jax import lax
import numpy as np

D_MODEL = 2048
BATCH = 4
SEQ = 8192
DEPTH = 1

CTX_LEN = 256
GRID_W = 64
HEAD_DIM = 128
ATTN_Q_HEADS = 8
ATTN_KV_HEADS = 2
ATTN_GROUPS = ATTN_Q_HEADS // ATTN_KV_HEADS
ATTN_WIDTH = ATTN_Q_HEADS * HEAD_DIM
KV_WIDTH = ATTN_KV_HEADS * HEAD_DIM
RET_HEADS = 8
RET_QK_DIM = 128
RET_V_DIM = 128
RET_QK_WIDTH = RET_HEADS * RET_QK_DIM
RET_V_WIDTH = RET_HEADS * RET_V_DIM
D_FF = 5632
Q_BLOCK = 128
RET_CHUNK = 128
ROPE_THETA = 10000.0
NORM_EPS = 1e-6
N_MOD = 9
PROJ_SPLITS = (ATTN_WIDTH, KV_WIDTH, KV_WIDTH, RET_QK_WIDTH, RET_QK_WIDTH, RET_V_WIDTH, RET_V_WIDTH, D_MODEL, D_MODEL)
PROJ_WIDTH = ATTN_WIDTH + 2 * KV_WIDTH + 2 * RET_QK_WIDTH + 2 * RET_V_WIDTH + 2 * D_MODEL

kernel_name = "hybrid_gqa_retention_macaron_dit_block"


def _rms(x):
    xf = x.astype(jnp.float32)
    return (xf * lax.rsqrt(jnp.mean(xf * xf, axis=-1, keepdims=True) + NORM_EPS)).astype(x.dtype)


def _modulate(n, shift, scale):
    return n * (1 + scale) + shift


def _adaln(cond, w_ada, b_ada):
    return jnp.split(jax.nn.silu(cond) @ w_ada + b_ada, N_MOD, axis=-1)


def _swiglu(x, w_in, w_out):
    a, b = jnp.split(x @ w_in, 2, axis=-1)
    return (jax.nn.silu(a) * b) @ w_out


def _split_proj(p):
    cuts = []
    acc = 0
    for w in PROJ_SPLITS[:-1]:
        acc += w
        cuts.append(acc)
    return jnp.split(p, cuts, axis=-1)


def _heads(t, n_heads, d):
    return t.reshape(t.shape[:2] + (n_heads, d))


def _grid_rope(seq_len):
    rows = seq_len // GRID_W
    row = jnp.repeat(jnp.arange(rows, dtype=jnp.float32), GRID_W)
    col = jnp.tile(jnp.arange(GRID_W, dtype=jnp.float32), rows)
    half = HEAD_DIM // 2
    inv_freq = ROPE_THETA ** (-jnp.arange(0, half, 2, dtype=jnp.float32) / half)
    ang = jnp.concatenate([row[:, None] * inv_freq, col[:, None] * inv_freq], axis=-1)
    return jnp.cos(ang), jnp.sin(ang)


def _apply_rope(x, cos, sin):
    xf = x.astype(jnp.float32).reshape(x.shape[:-1] + (HEAD_DIM // 2, 2))
    x0, x1 = xf[..., 0], xf[..., 1]
    c, s = cos[:, None, :], sin[:, None, :]
    out = jnp.stack([x0 * c - x1 * s, x0 * s + x1 * c], axis=-1)
    return out.reshape(x.shape).astype(x.dtype)


def _attend_blocks(q, k, v):
    b, l = q.shape[:2]
    nb = l // Q_BLOCK
    qb = jnp.moveaxis(q.reshape(b, nb, Q_BLOCK, ATTN_KV_HEADS, ATTN_GROUPS, HEAD_DIM), 1, 0)
    scale = HEAD_DIM ** -0.5

    def one_block(qblk):
        s = jnp.einsum("bqkgd,bskd->bkgqs", qblk, k).astype(jnp.float32) * scale
        p = jax.nn.softmax(s, axis=-1)
        return jnp.einsum("bkgqs,bskd->bqkgd", p.astype(v.dtype), v)

    out = lax.map(one_block, qb)
    return jnp.moveaxis(out, 0, 1).reshape(b, l, ATTN_WIDTH)


def _retention_chunkwise(q, k, v, log_gamma, state0):
    b, h, l, _ = q.shape
    n = l // RET_CHUNK
    idx = jnp.arange(RET_CHUNK, dtype=jnp.float32)
    diff = idx[:, None] - idx[None, :]
    lower = diff >= 0
    intra = jnp.where(lower[None], jnp.exp(jnp.where(lower, diff, 0.0)[None] * log_gamma[:, None, None]), 0.0)
    q_dec = jnp.exp((idx + 1.0)[None, :] * log_gamma[:, None])
    k_dec = jnp.exp((RET_CHUNK - 1.0 - idx)[None, :] * log_gamma[:, None])
    chunk_dec = jnp.exp(RET_CHUNK * log_gamma)

    def chunks(t):
        return jnp.moveaxis(t.reshape(b, h, n, RET_CHUNK, t.shape[-1]), 2, 0)

    def step(state, qkv):
        qc, kc, vc = qkv
        inner = jnp.einsum("bhid,bhjd->bhij", qc, kc) * intra
        y = jnp.einsum("bhij,bhje->bhie", inner, vc) + jnp.einsum("bhid,bhde->bhie", qc, state) * q_dec[..., None]
        state = state * chunk_dec[:, None, None] + jnp.einsum("bhjd,bhje->bhde", kc * k_dec[..., None], vc)
        return state, y

    _, ys = lax.scan(step, state0, (chunks(q), chunks(k), chunks(v)))
    return jnp.moveaxis(ys, 0, 2).reshape(b, h, l, v.shape[-1])


def _retention_state(k, v, log_gamma, reverse):
    l = k.shape[2]
    m = jnp.arange(l, dtype=jnp.float32)
    expo = m if reverse else (l - 1.0 - m)
    w = jnp.exp(expo[None, :] * log_gamma[:, None])
    return jnp.einsum("bhld,bhle,hl->bhde", k, v, w)


def _retention_bidir(q, k, v, lg_fwd, lg_bwd, state_fwd, state_bwd):
    flip = lambda t: jnp.flip(t, axis=2)
    y_f = _retention_chunkwise(q, k, v, lg_fwd, state_fwd)
    y_b = flip(_retention_chunkwise(flip(q), flip(k), flip(v), lg_bwd, state_bwd))
    return y_f + y_b


def _ret_heads(t, d):
    return jnp.transpose(_heads(t, RET_HEADS, d), (0, 2, 1, 3)).astype(jnp.float32)


def _retention_out(y, gate):
    b, h, l, d = y.shape
    y = jnp.transpose(_rms(y), (0, 2, 1, 3)).reshape(b, l, h * d).astype(gate.dtype)
    return jax.nn.silu(gate) * y


def _merge(y_attn, y_ret, g_attn, g_ret, w_proj_attn, w_proj_ret, w_out):
    return (jax.nn.sigmoid(g_attn) * (y_attn @ w_proj_attn) + jax.nn.sigmoid(g_ret) * (y_ret @ w_proj_ret)) @ w_out


def _mixer(n_x, n_c, w_in, q_gain, k_gain, decay_logit, w_proj_attn, w_proj_ret, w_out, with_ctx_out):
    seq_len = n_x.shape[1]
    qa_x, ka_x, va_x, qr_x, kr_x, vr_x, gr_x, ga_x, gb_x = _split_proj(n_x @ w_in)
    qa_c, ka_c, va_c, qr_c, kr_c, vr_c, gr_c, ga_c, gb_c = _split_proj(n_c @ w_in)

    cos, sin = _grid_rope(seq_len)
    q_x = _apply_rope(_rms(_heads(qa_x, ATTN_Q_HEADS, HEAD_DIM)) * q_gain, cos, sin)
    k_x = _apply_rope(_rms(_heads(ka_x, ATTN_KV_HEADS, HEAD_DIM)) * k_gain, cos, sin)
    k_c = _rms(_heads(ka_c, ATTN_KV_HEADS, HEAD_DIM)) * k_gain
    v_x = _heads(va_x, ATTN_KV_HEADS, HEAD_DIM)
    v_c = _heads(va_c, ATTN_KV_HEADS, HEAD_DIM)
    k_all = jnp.concatenate([k_c, k_x], axis=1)
    v_all = jnp.concatenate([v_c, v_x], axis=1)
    ya_x = _attend_blocks(q_x, k_all, v_all)

    log_gamma = jax.nn.log_sigmoid(decay_logit.astype(jnp.float32))
    k_scale = RET_QK_DIM ** -0.5
    qr_xh, kr_xh, vr_xh = _ret_heads(qr_x, RET_QK_DIM), _ret_heads(kr_x, RET_QK_DIM) * k_scale, _ret_heads(vr_x, RET_V_DIM)
    kr_ch, vr_ch = _ret_heads(kr_c, RET_QK_DIM) * k_scale, _ret_heads(vr_c, RET_V_DIM)
    state_f = _retention_state(kr_ch, vr_ch, log_gamma[0], False)
    state_b = _retention_state(kr_ch, vr_ch, log_gamma[1], True)
    yr_x = _retention_out(_retention_bidir(qr_xh, kr_xh, vr_xh, log_gamma[0], log_gamma[1], state_f, state_b), gr_x)

    out_x = _merge(ya_x, yr_x, ga_x, gb_x, w_proj_attn, w_proj_ret, w_out)
    if not with_ctx_out:
        return out_x, None

    q_c = _rms(_heads(qa_c, ATTN_Q_HEADS, HEAD_DIM)) * q_gain
    ya_c = _attend_blocks(q_c, k_c, v_c)
    zeros = jnp.zeros_like(state_f)
    qr_ch = _ret_heads(qr_c, RET_QK_DIM)
    yr_c = _retention_out(_retention_bidir(qr_ch, kr_ch, vr_ch, log_gamma[0], log_gamma[1], zeros, zeros), gr_c)
    out_c = _merge(ya_c, yr_c, ga_c, gb_c, w_proj_attn, w_proj_ret, w_out)
    return out_x, out_c


def setup_inputs(seed: int = 0) -> dict:
    key = jax.random.key(seed)
    ks = jax.random.split(key, 18)

    def nrm(k, shape, std):
        return jax.random.normal(k, shape, jnp.float32) * std

    heads_idx = jnp.arange(RET_HEADS, dtype=jnp.float32)
    decay_base = jnp.log1p(-(2.0 ** (-(5.0 + heads_idx)))) + (5.0 + heads_idx) * jnp.log(2.0)
    return {
        "x": nrm(ks[0], (BATCH, SEQ, D_MODEL), 1.0),
        "c": nrm(ks[1], (BATCH, D_MODEL), 1.0),
        "ctx": nrm(ks[2], (BATCH, CTX_LEN, D_MODEL), 1.0),
        "c_ctx": nrm(ks[3], (D_MODEL,), 1.0),
        "w_ada": nrm(ks[4], (DEPTH, D_MODEL, N_MOD * D_MODEL), 0.5 * D_MODEL ** -0.5),
        "b_ada": nrm(ks[5], (DEPTH, N_MOD * D_MODEL), 0.01),
        "ffn1_w_in": nrm(ks[6], (DEPTH, D_MODEL, 2 * D_FF), D_MODEL ** -0.5),
        "ffn1_w_out": nrm(ks[7], (DEPTH, D_FF, D_MODEL), D_FF ** -0.5),
        "mix_w_in": nrm(ks[8], (DEPTH, D_MODEL, PROJ_WIDTH), D_MODEL ** -0.5),
        "attn_q_gain": 1.0 + nrm(ks[9], (DEPTH, HEAD_DIM), 0.02),
        "attn_k_gain": 1.0 + nrm(ks[10], (DEPTH, HEAD_DIM), 0.02),
        "ret_decay_logit": decay_base[None, None, :] + nrm(ks[11], (DEPTH, 2, RET_HEADS), 0.1),
        "w_proj_attn": nrm(ks[12], (DEPTH, ATTN_WIDTH, D_MODEL), ATTN_WIDTH ** -0.5),
        "w_proj_ret": nrm(ks[13], (DEPTH, RET_V_WIDTH, D_MODEL), RET_V_WIDTH ** -0.5),
        "mix_w_out": nrm(ks[14], (DEPTH, D_MODEL, D_MODEL), D_MODEL ** -0.5),
        "ffn2_w_in": nrm(ks[15], (DEPTH, D_MODEL, 2 * D_FF), D_MODEL ** -0.5),
        "ffn2_w_out": nrm(ks[16], (DEPTH, D_FF, D_MODEL), D_FF ** -0.5),
        "final_norm": 1.0 + nrm(ks[17], (D_MODEL,), 0.02),
    }


def reference(x, c, ctx, c_ctx, w_ada, b_ada, ffn1_w_in, ffn1_w_out, mix_w_in, attn_q_gain, attn_k_gain,
              ret_decay_logit, w_proj_attn, w_proj_ret, mix_w_out, ffn2_w_in, ffn2_w_out, final_norm):
    h_x = x
    h_c = ctx
    for layer in range(DEPTH):
        last = layer == DEPTH - 1
        sh1, sc1, g1, sh2, sc2, g2, sh3, sc3, g3 = [t[:, None, :] for t in _adaln(c, w_ada[layer], b_ada[layer])]
        csh1, csc1, cg1, csh2, csc2, cg2, csh3, csc3, cg3 = _adaln(c_ctx, w_ada[layer], b_ada[layer])

        h_x = h_x + 0.5 * g1 * _swiglu(_modulate(_rms(h_x), sh1, sc1), ffn1_w_in[layer], ffn1_w_out[layer])
        h_c = h_c + 0.5 * cg1 * _swiglu(_modulate(_rms(h_c), csh1, csc1), ffn1_w_in[layer], ffn1_w_out[layer])

        y_x, y_c = _mixer(_modulate(_rms(h_x), sh2, sc2), _modulate(_rms(h_c), csh2, csc2),
                          mix_w_in[layer], attn_q_gain[layer], attn_k_gain[layer], ret_decay_logit[layer],
                          w_proj_attn[layer], w_proj_ret[layer], mix_w_out[layer], not last)
        h_x = h_x + g2 * y_x

        h_x = h_x + 0.5 * g3 * _swiglu(_modulate(_rms(h_x), sh3, sc3), ffn2_w_in[layer], ffn2_w_out[layer])
        if not last:
            h_c = h_c + cg2 * y_c
            h_c = h_c + 0.5 * cg3 * _swiglu(_modulate(_rms(h_c), csh3, csc3), ffn2_w_in[layer], ffn2_w_out[layer])
    return _rms(h_x) * final_norm
```

```cpp
#include <hip/hip_runtime.h>
#include <hip/hip_cooperative_groups.h>
#include <cstdio>
#include <cstdint>
namespace cg = cooperative_groups;

constexpr int NB = 4, SEQ = 8192, DM = 2048, CTX = 256, TX = NB * SEQ, TC = NB * CTX, TT = TX + TC;
constexpr int DFF = 5632, PW = 9728, NMODW = 9 * DM;
constexpr int NCH = SEQ / 128, NEC = NCH + 2;
constexpr float NEPS = 1e-6f;

typedef unsigned short bf16_t;
typedef short bf16x8 __attribute__((ext_vector_type(8)));
typedef short s16x4 __attribute__((ext_vector_type(4)));
typedef float f32x4 __attribute__((ext_vector_type(4)));
typedef float f32x16 __attribute__((ext_vector_type(16)));
typedef unsigned u32x4 __attribute__((ext_vector_type(4)));
typedef unsigned u32x2 __attribute__((ext_vector_type(2)));
typedef float f32x2_t __attribute__((ext_vector_type(2)));
typedef __bf16 bf16x2_t __attribute__((ext_vector_type(2)));

constexpr size_t MiB = 1u << 20;
constexpr size_t WS_MOD = 0;
constexpr size_t WS_HC = 1 * MiB;
constexpr size_t WS_W1 = 9 * MiB;
constexpr size_t WS_W2 = 53 * MiB;
constexpr size_t WS_WIN = 75 * MiB;
constexpr size_t WS_WPA = 113 * MiB;
constexpr size_t WS_WPR = 117 * MiB;
constexpr size_t WS_WO = 121 * MiB;
constexpr size_t WS_W3 = 129 * MiB;
constexpr size_t WS_W4 = 173 * MiB;
constexpr size_t WS_XN = 195 * MiB;
constexpr size_t WS_KVF = WS_XN, WS_KVB = WS_XN + 66 * MiB;
constexpr size_t WS_R = 327 * MiB;
constexpr size_t WS_QA = WS_R, WS_KA = WS_R + 66 * MiB, WS_VA = WS_KA + 33 * MiB / 2, WS_QR = WS_R + 99 * MiB, WS_KR = WS_R + 165 * MiB,
                 WS_VR = WS_R + 231 * MiB, WS_GR = WS_R + 297 * MiB, WS_GA = WS_R + 363 * MiB, WS_GB = WS_R + 495 * MiB, WS_END = WS_R + 627 * MiB;
constexpr size_t WS_PART = WS_R + 400 * MiB;
constexpr int LDS_BYTES = 147456;

#define DI __device__ __forceinline__
DI unsigned f2bf(float f) { unsigned u = __builtin_bit_cast(unsigned, f); return (u + 0x7fffu + ((u >> 16) & 1u)) >> 16; }
DI unsigned pk2(float lo, float hi) { f32x2_t v = {lo, hi}; bf16x2_t b = __builtin_convertvector(v, bf16x2_t); return __builtin_bit_cast(unsigned, b); }
DI float bflo(unsigned w) { return __builtin_bit_cast(float, w << 16); }
DI float bfhi(unsigned w) { return __builtin_bit_cast(float, w & 0xffff0000u); }
DI float wave_sum(float v) {
#pragma unroll
    for (int o = 1; o < 64; o <<= 1) v += __shfl_xor(v, o);
    return v;
}
DI float sigmoidf_(float x) { return __builtin_amdgcn_rcpf(1.f + __expf(-x)); }
DI float siluf_(float x) { return x * sigmoidf_(x); }
#define LDS_WAIT() asm volatile("s_waitcnt lgkmcnt(0)" ::: "memory")

namespace pg8 {
#define PG8_LAS __attribute__((address_space(3)))
constexpr int BM = 256, BK = 64, HALF = 128, HTB = HALF * BK * 2, STAGE_BYTES = 8 * HTB, NXCD = 8, WGM = 8;
__host__ __device__ __forceinline__ int lds_byte(int r, int c) { const int st = (r >> 4) * 2 + (c >> 5), rr = r & 15, cc = c & 31, ob = rr * 64 + cc * 2; return st * 1024 + (ob ^ (((ob >> 9) & 1) << 5)); }
__host__ __device__ __forceinline__ void stage_rc(int b, int& R, int& C) { const int st = b / 1024, sb = b % 1024, swz = sb ^ (((sb >> 9) & 1) << 5); R = (st >> 1) * 16 + swz / 64; C = (st & 1) * 32 + (swz % 64) / 2; }
__host__ __device__ __forceinline__ int perm32(int rho) { const int n = rho >> 4, i = rho & 15; return 8 * (i >> 2) + 4 * n + (i & 3); }
struct Unit { int pm, pn, kt0, nt; };
struct Gemm { const bf16_t* A; const bf16_t* Bt; int M, N, K; };
struct StaticOrder {
    int nM, nN, nwg, G, c, ntk;
    __host__ __device__ void init(int M, int N, int K, int G_, int c_) { nM = M / BM; nN = N / BM; nwg = nM * nN; G = G_; c = c_; ntk = K / BK; }
    __host__ __device__ bool next(int i, Unit& u) const {
        const long L = (long)i * G + c; if (L >= nwg) return false;
        int wgid = (int)L; { const int q = nwg / NXCD, r = nwg % NXCD, xcd = wgid % NXCD, off = wgid / NXCD; wgid = (xcd < r ? xcd * (q + 1) : r * (q + 1) + (xcd - r) * q) + off; }
        const int nig = WGM * nN, gid = wgid / nig, fm = gid * WGM, gsz = (nM - fm) < WGM ? (nM - fm) : WGM;
        u.pm = fm + ((wgid % nig) % gsz); u.pn = (wgid % nig) / gsz; u.kt0 = 0; u.nt = ntk; return true;
    }
};
struct OrderDown1 {
    StaticOrder lat; int G, c;
    __host__ __device__ void init(int G_, int c_) { lat.init(TX, DM, DFF, G_, c_); G = G_; c = c_; }
    __host__ __device__ bool next(int i, Unit& u) const {
        const long L = (long)i * G + c; if (L < lat.nwg) return lat.next(i, u);
        const int j = (int)(L - lat.nwg); if (j >= 128) return false;
        u.kt0 = (j & 3) * 22; u.nt = 22; u.pn = (j >> 2) & 7; u.pm = TX / BM + (j >> 5); return true;
    }
};
template <class Epi, class Sched>
__device__ __forceinline__ void gemm_phase(PG8_LAS unsigned char* lds, const Gemm g, const Sched& S, const Epi& E) {
    int tid = threadIdx.x; asm volatile("" : "+v"(tid));
    const int wid = __builtin_amdgcn_readfirstlane(tid >> 6), lane = tid & 63, wr = wid >> 2, wc = wid & 3, fr = lane & 15, fq = lane >> 4;
    const int K = g.K;
    unsigned voffA[2], voffB[2];
#pragma unroll
    for (int i = 0; i < 2; ++i) { int R, C; stage_rc(tid * 16 + i * 8192, R, C); const int Rb = Epi::PERM ? ((R & ~31) + perm32(R & 31)) : R;
        voffA[i] = (unsigned)(R * K + C) * 2u; voffB[i] = (unsigned)(Rb * K + C) * 2u; }
    const size_t kstep = (size_t)(BK * 2);
    const size_t hstep = (size_t)HALF * K * 2;
    const size_t tstep = 2 * hstep;
    const unsigned ldsw = (unsigned)wid * 1024u;
    const int aoff = lds_byte(wr * 64 + fr, fq * 8), boff = lds_byte(wc * 32 + fr, fq * 8);
#define PG8_SA(b, h) (((b) * 2 + (h)) * HTB)
#define PG8_SB(b, h) ((4 + (b) * 2 + (h)) * HTB)
#define PG8_STAGE(bufoff, gbase, voff) do { _Pragma("unroll") for (int _i = 0; _i < 2; ++_i) \
        __builtin_amdgcn_global_load_lds((const unsigned*)((const char*)(gbase) + (voff)[_i]), (PG8_LAS unsigned*)(lds + (bufoff) + ldsw + _i * 8192), 16, 0, 0); } while (0)
#define PG8_LDA(dst, b, h) do { _Pragma("unroll") for (int m = 0; m < 4; ++m) _Pragma("unroll") for (int k = 0; k < 2; ++k) dst[m][k] = *(const PG8_LAS bf16x8*)(lds + PG8_SA(b, h) + aoff + m * 2048 + k * 1024); } while (0)
#define PG8_LDB(dst, b, h) do { _Pragma("unroll") for (int n = 0; n < 2; ++n) _Pragma("unroll") for (int k = 0; k < 2; ++k) dst[n][k] = *(const PG8_LAS bf16x8*)(lds + PG8_SB(b, h) + boff + n * 2048 + k * 1024); } while (0)
#define PG8_MMA(ai, bj, At, Bt) do { __builtin_amdgcn_s_setprio(1); _Pragma("unroll") for (int m = 0; m < 4; ++m) _Pragma("unroll") for (int n = 0; n < 2; ++n) _Pragma("unroll") for (int k = 0; k < 2; ++k) \
        acc[ai][bj][m][n] = __builtin_amdgcn_mfma_f32_16x16x32_bf16(Bt[n][k], At[m][k], acc[ai][bj][m][n], 0, 0, 0); __builtin_amdgcn_s_setprio(0); } while (0)
#define PG8_WAIT_V(n) asm volatile("s_waitcnt vmcnt(" #n ")" ::: "memory")
#define PG8_WAIT_L(n) asm volatile("s_waitcnt lgkmcnt(" #n ")" ::: "memory")
#define PG8_BAR __builtin_amdgcn_s_barrier()
#define PG8_SCHED __builtin_amdgcn_sched_barrier(0)
    Unit cur, nxt; int ui = 0;
    if (!S.next(0, cur)) return;
    f32x4 acc[2][2][4][2];
#pragma unroll
    for (int a = 0; a < 2; ++a)
#pragma unroll
        for (int b = 0; b < 2; ++b)
#pragma unroll
            for (int m = 0; m < 4; ++m)
#pragma unroll
                for (int n = 0; n < 2; ++n) acc[a][b][m][n] = (f32x4){0.f, 0.f, 0.f, 0.f};
    bf16x8 At[4][2], B0[2][2], B1[2][2];
    const char* cA = (const char*)g.A + (size_t)cur.pm * tstep + (size_t)cur.kt0 * kstep; const char* cB = (const char*)g.Bt + (size_t)cur.pn * tstep + (size_t)cur.kt0 * kstep;
    {
        PG8_STAGE(PG8_SB(0, 0), cB, voffB); PG8_STAGE(PG8_SB(0, 1), cB + hstep, voffB); PG8_STAGE(PG8_SA(0, 0), cA, voffA); PG8_STAGE(PG8_SA(0, 1), cA + hstep, voffA);
        if (wr == 1) PG8_BAR;
        PG8_WAIT_V(2); PG8_BAR;
        PG8_STAGE(PG8_SB(1, 0), cB + kstep, voffB); PG8_STAGE(PG8_SA(1, 0), cA + kstep, voffA); PG8_STAGE(PG8_SB(1, 1), cB + hstep + kstep, voffB);
        PG8_WAIT_V(6); PG8_BAR;
    }
    for (;;) {
        const bool has_next = S.next(ui + 1, nxt);
        const char* nA = has_next ? (const char*)g.A + (size_t)nxt.pm * tstep + (size_t)nxt.kt0 * kstep : cA; const char* nB = has_next ? (const char*)g.Bt + (size_t)nxt.pn * tstep + (size_t)nxt.kt0 * kstep : cB;
        const int nt = cur.nt;
        for (int t = 0; t < nt; t += 2) {
            const bool last = (t == nt - 2);
            const char* a1 = cA + (size_t)(t + 1) * kstep;
            const char* a2 = last ? nA : cA + (size_t)(t + 2) * kstep; const char* b2 = last ? nB : cB + (size_t)(t + 2) * kstep;
            const char* a3 = a2 + kstep; const char* b3 = b2 + kstep;
            PG8_LDB(B0, 0, 0); PG8_LDB(B1, 0, 1); PG8_SCHED; PG8_LDA(At, 0, 0); PG8_STAGE(PG8_SA(1, 1), a1 + hstep, voffA);
            PG8_WAIT_V(8); PG8_WAIT_L(0); PG8_BAR; PG8_MMA(0, 0, At, B0); PG8_MMA(0, 1, At, B1); PG8_BAR; PG8_SCHED;
            PG8_LDA(At, 0, 1); PG8_STAGE(PG8_SB(0, 0), b2, voffB); PG8_STAGE(PG8_SB(0, 1), b2 + hstep, voffB); PG8_STAGE(PG8_SA(0, 0), a2, voffA);
            PG8_WAIT_V(8); PG8_WAIT_L(0); PG8_BAR; PG8_MMA(1, 0, At, B0); PG8_MMA(1, 1, At, B1); PG8_BAR; PG8_SCHED;
            PG8_LDB(B0, 1, 0); PG8_LDB(B1, 1, 1); PG8_SCHED; PG8_LDA(At, 1, 0); PG8_STAGE(PG8_SA(0, 1), a2 + hstep, voffA);
            PG8_WAIT_V(8); PG8_WAIT_L(0); PG8_BAR; PG8_MMA(0, 0, At, B0); PG8_MMA(0, 1, At, B1); PG8_BAR; PG8_SCHED;
            PG8_LDA(At, 1, 1); PG8_STAGE(PG8_SB(1, 0), b3, voffB); PG8_STAGE(PG8_SB(1, 1), b3 + hstep, voffB); PG8_STAGE(PG8_SA(1, 0), a3, voffA);
            PG8_WAIT_V(8); PG8_WAIT_L(0); PG8_BAR; PG8_MMA(1, 0, At, B0); PG8_MMA(1, 1, At, B1); PG8_BAR; PG8_SCHED;
        }
        if (wr == 0) PG8_BAR;
        E(acc, cur, wr, wc, fr, fq);
        if (!has_next) break;
#pragma unroll
        for (int a = 0; a < 2; ++a)
#pragma unroll
            for (int b = 0; b < 2; ++b)
#pragma unroll
                for (int m = 0; m < 4; ++m)
#pragma unroll
                    for (int n = 0; n < 2; ++n) acc[a][b][m][n] = (f32x4){0.f, 0.f, 0.f, 0.f};
        cur = nxt; cA = nA; cB = nB; ++ui;
        if (wr == 1) PG8_BAR;
    }
    PG8_WAIT_V(0);
    PG8_BAR;
#undef PG8_SA
#undef PG8_SB
#undef PG8_STAGE
#undef PG8_LDA
#undef PG8_LDB
#undef PG8_MMA
#undef PG8_WAIT_V
#undef PG8_WAIT_L
#undef PG8_BAR
#undef PG8_SCHED
}

struct EpiSwiglu {
    static constexpr bool PERM = true;
    bf16_t* O;
    __device__ __forceinline__ void operator()(const f32x4 (&acc)[2][2][4][2], const Unit& u, int wr, int wc, int fr, int fq) const {
        const int row0 = u.pm * BM + wr * 64 + fr; const int col0 = u.pn * HALF + wc * 32 + 8 * fq;
#pragma unroll
        for (int ai = 0; ai < 2; ++ai)
#pragma unroll
            for (int m = 0; m < 4; ++m) {
                bf16_t* rowp = O + (size_t)(row0 + ai * HALF + m * 16) * DFF + col0;
                const f32x4 a0 = acc[ai][0][m][0], a1 = acc[ai][0][m][1], b0 = acc[ai][1][m][0], b1 = acc[ai][1][m][1];
                u32x4 w;
                w.x = pk2(siluf_(a0[0]) * b0[0], siluf_(a0[1]) * b0[1]); w.y = pk2(siluf_(a0[2]) * b0[2], siluf_(a0[3]) * b0[3]);
                w.z = pk2(siluf_(a1[0]) * b1[0], siluf_(a1[1]) * b1[1]); w.w = pk2(siluf_(a1[2]) * b1[2], siluf_(a1[3]) * b1[3]);
                *(u32x4*)rowp = w;
            }
    }
};
struct EpiResid {
    static constexpr bool PERM = false;
    const float* basex; const float* basec; float* outx; float* outc; const float* gate; float scale;
    __device__ __forceinline__ void operator()(const f32x4 (&acc)[2][2][4][2], const Unit& u, int wr, int wc, int fr, int fq) const {
        const bool isx = u.pm < TX / BM;
        const int col0 = u.pn * BM + wc * 32 + 4 * fq;
        if (!isx) {
            float* po = outc + ((size_t)(u.kt0 / 22) * TC + (size_t)(u.pm - TX / BM) * BM) * DM;
#pragma unroll
            for (int ai = 0; ai < 2; ++ai)
#pragma unroll
                for (int m = 0; m < 4; ++m) { const size_t off = (size_t)(wr * 64 + ai * HALF + m * 16 + fr) * DM + col0;
#pragma unroll
                    for (int bj = 0; bj < 2; ++bj)
#pragma unroll
                        for (int n = 0; n < 2; ++n) *(f32x4*)(po + off + bj * HALF + n * 16) = acc[ai][bj][m][n]; }
            return;
        }
        const int bidx = u.pm >> 5;
        const float* base = basex + (size_t)u.pm * BM * DM;
        float* out = outx + (size_t)u.pm * BM * DM;
        f32x4 gv[2][2];
#pragma unroll
        for (int bj = 0; bj < 2; ++bj)
#pragma unroll
            for (int n = 0; n < 2; ++n) gv[bj][n] = *(const f32x4*)(gate + (size_t)bidx * NMODW + col0 + bj * HALF + n * 16) * scale;
#pragma unroll
        for (int ai = 0; ai < 2; ++ai)
#pragma unroll
            for (int m = 0; m < 4; ++m) { const size_t off = (size_t)(wr * 64 + ai * HALF + m * 16 + fr) * DM + col0;
#pragma unroll
                for (int bj = 0; bj < 2; ++bj)
#pragma unroll
                    for (int n = 0; n < 2; ++n) { const f32x4 bs = *(const f32x4*)(base + off + bj * HALF + n * 16);
                        *(f32x4*)(out + off + bj * HALF + n * 16) = bs + gv[bj][n] * acc[ai][bj][m][n]; } }
    }
};
struct EpiProj {
    static constexpr bool PERM = true;
    unsigned char* ws;
    __device__ __forceinline__ void operator()(const f32x4 (&acc)[2][2][4][2], const Unit& u, int wr, int wc, int fr, int fq) const {
        const int pn = u.pn; size_t boff; int ldc, ct; float sc = 1.f;
        if (pn < 4) { boff = WS_QA; ldc = 1024; ct = pn; }
        else if (pn < 5) { boff = WS_KA; ldc = 256; ct = 0; }
        else if (pn < 6) { boff = WS_VA; ldc = 256; ct = 0; }
        else if (pn < 10) { boff = WS_QR; ldc = 1024; ct = pn - 6; }
        else if (pn < 14) { boff = WS_KR; ldc = 1024; ct = pn - 10; sc = 0.08838834764831845f; }
        else if (pn < 18) { boff = WS_VR; ldc = 1024; ct = pn - 14; }
        else if (pn < 22) { boff = WS_GR; ldc = 1024; ct = pn - 18; }
        else if (pn < 30) { boff = WS_GA; ldc = 2048; ct = pn - 22; }
        else { boff = WS_GB; ldc = 2048; ct = pn - 30; }
        bf16_t* O = (bf16_t*)(ws + boff);
        const int row0 = u.pm * BM + wr * 64 + fr; const int col0 = ct * BM + wc * 32 + 8 * fq;
#pragma unroll
        for (int ai = 0; ai < 2; ++ai)
#pragma unroll
            for (int m = 0; m < 4; ++m) { bf16_t* rowp = O + (size_t)(row0 + ai * HALF + m * 16) * ldc + col0;
#pragma unroll
                for (int bj = 0; bj < 2; ++bj) { const f32x4 v0 = acc[ai][bj][m][0] * sc, v1 = acc[ai][bj][m][1] * sc;
                    u32x4 w; w.x = pk2(v0[0], v0[1]); w.y = pk2(v0[2], v0[3]); w.z = pk2(v1[0], v1[1]); w.w = pk2(v1[2], v1[3]);
                    *(u32x4*)(rowp + bj * HALF) = w; } }
    }
};
template <int MODE> struct EpiMerge {
    static constexpr bool PERM = true;
    bf16_t* GA; const bf16_t* GB;
    __device__ __forceinline__ void operator()(const f32x4 (&acc)[2][2][4][2], const Unit& u, int wr, int wc, int fr, int fq) const {
        const int row0 = u.pm * BM + wr * 64 + fr; const int col0 = u.pn * BM + wc * 32 + 8 * fq;
#pragma unroll
        for (int ai = 0; ai < 2; ++ai)
#pragma unroll
            for (int m = 0; m < 4; ++m) { const size_t off = (size_t)(row0 + ai * HALF + m * 16) * DM + col0;
#pragma unroll
                for (int bj = 0; bj < 2; ++bj) { const f32x4 v0 = acc[ai][bj][m][0], v1 = acc[ai][bj][m][1];
                    const u32x4 ga = *(const u32x4*)(GA + off + bj * HALF); u32x4 w;
                    if (MODE == 0) {
                        w.x = pk2(sigmoidf_(bflo(ga.x)) * v0[0], sigmoidf_(bfhi(ga.x)) * v0[1]); w.y = pk2(sigmoidf_(bflo(ga.y)) * v0[2], sigmoidf_(bfhi(ga.y)) * v0[3]);
                        w.z = pk2(sigmoidf_(bflo(ga.z)) * v1[0], sigmoidf_(bfhi(ga.z)) * v1[1]); w.w = pk2(sigmoidf_(bflo(ga.w)) * v1[2], sigmoidf_(bfhi(ga.w)) * v1[3]);
                    } else {
                        const u32x4 gb = *(const u32x4*)(GB + off + bj * HALF);
                        w.x = pk2(bflo(ga.x) + sigmoidf_(bflo(gb.x)) * v0[0], bfhi(ga.x) + sigmoidf_(bfhi(gb.x)) * v0[1]); w.y = pk2(bflo(ga.y) + sigmoidf_(bflo(gb.y)) * v0[2], bfhi(ga.y) + sigmoidf_(bfhi(gb.y)) * v0[3]);
                        w.z = pk2(bflo(ga.z) + sigmoidf_(bflo(gb.z)) * v1[0], bfhi(ga.z) + sigmoidf_(bfhi(gb.z)) * v1[1]); w.w = pk2(bflo(ga.w) + sigmoidf_(bflo(gb.w)) * v1[2], bfhi(ga.w) + sigmoidf_(bfhi(gb.w)) * v1[3]);
                    }
                    *(u32x4*)(GA + off + bj * HALF) = w; } }
    }
};
}

namespace att {
constexpr int D = 128, NW = 8, QBLK = 32, KVBLK = 64;
constexpr float SCALE = 0.088388347648318440f;
constexpr float THR = 8.f;
constexpr size_t SHM_V = KVBLK * D * 2, SHM_K = KVBLK * D * 2;
#define KSWZ(row, colB) ((row) * 256 + ((colB) ^ (((row) & 7) << 4)))
#define SBAR() __builtin_amdgcn_sched_barrier(0)
DI int crow(int r, int hi) { return (r & 3) + 8 * (r >> 2) + 4 * hi; }
DI unsigned cvtpk(float lo, float hi) { return pk2(lo, hi); }
DI void partialSM(f32x16& p0, f32x16& p1, float& m_reg, float& mn, float& alpha) {
    constexpr float C = SCALE * 1.4426950408889634f;
    float pmax = p0[0];
#pragma unroll
    for (int r = 1; r < 16; ++r) pmax = fmaxf(pmax, p0[r]);
#pragma unroll
    for (int r = 0; r < 16; ++r) pmax = fmaxf(pmax, p1[r]);
    { auto rr = __builtin_amdgcn_permlane32_swap(__float_as_uint(pmax), __float_as_uint(pmax), false, false);
      pmax = fmaxf(__uint_as_float(rr[0]), __uint_as_float(rr[1])); }
    if (__builtin_expect(__all(pmax - m_reg <= THR / SCALE), 1)) { mn = m_reg; alpha = 1.f; }
    else { mn = fmaxf(m_reg, pmax); alpha = __builtin_amdgcn_exp2f((m_reg - mn) * C); m_reg = mn; }
    float mnC = -mn * C;
#pragma unroll
    for (int r = 0; r < 16; ++r) p0[r] = fmaf(p0[r], C, mnC);
#pragma unroll
    for (int r = 0; r < 16; ++r) p1[r] = fmaf(p1[r], C, mnC);
#pragma unroll
    for (int r = 0; r < 16; ++r) p0[r] = __builtin_amdgcn_exp2f(p0[r]);
}
#define PK4(P, BASE, OUT) do { unsigned a0 = cvtpk(P[BASE + 0], P[BASE + 1]), a1 = cvtpk(P[BASE + 2], P[BASE + 3]);   \
    unsigned b0 = cvtpk(P[BASE + 4], P[BASE + 5]), b1 = cvtpk(P[BASE + 6], P[BASE + 7]);                              \
    auto r0 = __builtin_amdgcn_permlane32_swap(a0, b0, false, false); auto r1 = __builtin_amdgcn_permlane32_swap(a1, b1, false, false); \
    u32x4 w = {r0[0], r1[0], r0[1], r1[1]}; OUT = __builtin_bit_cast(bf16x8, w); } while (0)
DI void finishSM(f32x16& p0, f32x16& p1, float alpha, float& l_reg, bf16x8& pa0, bf16x8& pa1, bf16x8& pa2, bf16x8& pa3) {
#pragma unroll
    for (int r = 0; r < 16; ++r) p1[r] = __builtin_amdgcn_exp2f(p1[r]);
    float ps = 0;
#pragma unroll
    for (int r = 0; r < 16; ++r) ps += p0[r];
#pragma unroll
    for (int r = 0; r < 16; ++r) ps += p1[r];
    { auto rr = __builtin_amdgcn_permlane32_swap(__float_as_uint(ps), __float_as_uint(ps), false, false);
      ps = __uint_as_float(rr[0]) + __uint_as_float(rr[1]); }
    l_reg = l_reg * alpha + ps;
    PK4(p0, 0, pa0); PK4(p0, 8, pa1); PK4(p1, 0, pa2); PK4(p1, 8, pa3);
}
DI void packP(const f32x16& p0, const f32x16& p1, bf16x8& pa0, bf16x8& pa1, bf16x8& pa2, bf16x8& pa3) {
    PK4(p0, 0, pa0); PK4(p0, 8, pa1); PK4(p1, 0, pa2); PK4(p1, 8, pa3);
}
DI void qkt(f32x16& p0, f32x16& p1, const char* Ks, const bf16x8* qr, int r32, int hi) {
    p0 = f32x16{}; p1 = f32x16{};
#pragma unroll
    for (int d0 = 0; d0 < 8; ++d0) { int cb = (d0 * 16 + hi * 8) * 2;
        bf16x8 b0 = *reinterpret_cast<const bf16x8*>(Ks + KSWZ(r32, cb));
        bf16x8 b1 = *reinterpret_cast<const bf16x8*>(Ks + KSWZ(32 + r32, cb));
        p0 = __builtin_amdgcn_mfma_f32_32x32x16_bf16(b0, qr[d0], p0, 0, 0, 0);
        p1 = __builtin_amdgcn_mfma_f32_32x32x16_bf16(b1, qr[d0], p1, 0, 0, 0); }
}
DI int v_st(int k, int c) { const int kk = (k & ~0xC) | ((k & 4) << 1) | ((k & 8) >> 1); return ((kk >> 3) * 4 + (c >> 5)) * 512 + ((kk & 7) * 32 + (c & 31)) * 2; }
DI int v_rd_base(int lane) { return ((lane & 3) << 3) | (((lane >> 2) & 3) << 6) | (((lane >> 4) & 1) << 5) | (((lane >> 5) & 1) << 8); }
constexpr int v_rd_off(int d0, int ks, int half) { return d0 * 512 + ks * 4096 + half * 2048; }
template <int OFF> DI s16x4 tr_read(int vb) {
    s16x4 r; asm volatile("ds_read_b64_tr_b16 %0, %1 offset:%2" : "=&v"(r) : "v"(vb), "i"(OFF) : "memory"); return r;
}
#define PKLH(L, H) (bf16x8){L[0], L[1], L[2], L[3], H[0], H[1], H[2], H[3]}
template <int TOFF, int D0, int KS> DI bf16x8 frag(int vb) {
    const s16x4 l = tr_read<TOFF + v_rd_off(D0, KS, 0)>(vb), h = tr_read<TOFF + v_rd_off(D0, KS, 1)>(vb);
    asm volatile("s_waitcnt lgkmcnt(0)" ::: "memory");
    return PKLH(l, h);
}
template <int D0> DI void pv_one(f32x16& od, int vb, bf16x8 pa0, bf16x8 pa1, bf16x8 pa2, bf16x8 pa3) {
    const s16x4 l0 = tr_read<v_rd_off(D0, 0, 0)>(vb), h0 = tr_read<v_rd_off(D0, 0, 1)>(vb), l1 = tr_read<v_rd_off(D0, 1, 0)>(vb), h1 = tr_read<v_rd_off(D0, 1, 1)>(vb);
    const s16x4 l2 = tr_read<v_rd_off(D0, 2, 0)>(vb), h2 = tr_read<v_rd_off(D0, 2, 1)>(vb), l3 = tr_read<v_rd_off(D0, 3, 0)>(vb), h3 = tr_read<v_rd_off(D0, 3, 1)>(vb);
    asm volatile("s_waitcnt lgkmcnt(0)" ::: "memory"); SBAR();
    od = __builtin_amdgcn_mfma_f32_32x32x16_bf16(pa0, PKLH(l0, h0), od, 0, 0, 0);
    od = __builtin_amdgcn_mfma_f32_32x32x16_bf16(pa1, PKLH(l1, h1), od, 0, 0, 0);
    od = __builtin_amdgcn_mfma_f32_32x32x16_bf16(pa2, PKLH(l2, h2), od, 0, 0, 0);
    od = __builtin_amdgcn_mfma_f32_32x32x16_bf16(pa3, PKLH(l3, h3), od, 0, 0, 0);
}
DI void pv_d0(f32x16* o, int vb, bf16x8 pa0, bf16x8 pa1, bf16x8 pa2, bf16x8 pa3) {
    pv_one<0>(o[0], vb, pa0, pa1, pa2, pa3); pv_one<1>(o[1], vb, pa0, pa1, pa2, pa3); pv_one<2>(o[2], vb, pa0, pa1, pa2, pa3); pv_one<3>(o[3], vb, pa0, pa1, pa2, pa3);
}

constexpr int LDQ = 1024, LDK = 256, LDO = 1024;
DI void attn_unit(const bf16_t* Qb, const bf16_t* Kc, const bf16_t* Kx, const bf16_t* Vc, const bf16_t* Vx, bf16_t* Ob, char* lds) {
    int tid = threadIdx.x; asm volatile("" : "+v"(tid));
    const int wid = tid >> 6, lane = tid & 63, r32 = lane & 31, hi = lane >> 5;
    char* V_lds = lds; char* K_lds = lds + 2 * SHM_V;
    float* ws = (float*)(lds + 2 * SHM_V + 2 * SHM_K) + wid * 64; float* li_l = ws; float* al_l = ws + 32;
    float m_reg = -1e30f, l_reg = 0; f32x16 o[4] = {}; bf16x8 qr[8];
    const bf16_t* Qw = Qb + (long)(wid * QBLK + r32) * LDQ + hi * 8;
#pragma unroll
    for (int d0 = 0; d0 < 8; ++d0) qr[d0] = *reinterpret_cast<const bf16x8*>(Qw + d0 * 16);
    const int sr = tid >> 4, sc = (tid & 15) * 8, vst0 = v_st(sr, sc), vst1 = v_st(32 + sr, sc);
    const int vb0 = (int)(uintptr_t)V_lds + v_rd_base(lane);
    struct { bf16x8 vs0, vs1, ks0, ks1; } sr_[2];
#define KVP(P, k0) (((k0) < CTX ? P##c + (long)(k0) * LDK : P##x + (long)((k0) - CTX) * LDK))
#define SLOAD(i, k0) do { const bf16_t* vp_ = KVP(V, k0); const bf16_t* kp_ = KVP(K, k0); \
    sr_[i].vs0 = *reinterpret_cast<const bf16x8*>(&vp_[(long)sr * LDK + sc]); sr_[i].vs1 = *reinterpret_cast<const bf16x8*>(&vp_[(long)(32 + sr) * LDK + sc]); \
    sr_[i].ks0 = *reinterpret_cast<const bf16x8*>(&kp_[(long)sr * LDK + sc]); sr_[i].ks1 = *reinterpret_cast<const bf16x8*>(&kp_[(long)(32 + sr) * LDK + sc]); } while (0)
#define SWRITE(b, i) do { *(bf16x8*)(V_lds + (b) * SHM_V + vst0) = sr_[i].vs0;          \
    *(bf16x8*)(V_lds + (b) * SHM_V + vst1) = sr_[i].vs1; int kc = sc * 2;               \
    *(bf16x8*)(K_lds + (b) * SHM_K + KSWZ(sr, kc)) = sr_[i].ks0;                       \
    *(bf16x8*)(K_lds + (b) * SHM_K + KSWZ(32 + sr, kc)) = sr_[i].ks1; } while (0)
#define SWAIT() asm volatile("s_waitcnt vmcnt(4)" ::: "memory")
#define RESC(a) do { if (__any((a) < 1.f)) { if (hi == 0) al_l[r32] = (a); asm volatile("s_waitcnt lgkmcnt(0)" ::: "memory"); \
    _Pragma("unroll") for (int d = 0; d < 4; ++d) _Pragma("unroll") for (int r = 0; r < 16; ++r) o[d][r] *= al_l[crow(r, hi)]; } } while (0)
    f32x16 pA0, pA1, pB0, pB1; float mnA, mnB, alA, alB; bf16x8 pa0, pa1, pa2, pa3; constexpr int NT = (CTX + SEQ) / KVBLK;
    constexpr int SE = 0, SO = 1;
    SLOAD(SE, 0); asm volatile("s_waitcnt vmcnt(0)" ::: "memory"); SWRITE(0, SE); __syncthreads();
    qkt(pA0, pA1, K_lds, qr, r32, hi); partialSM(pA0, pA1, m_reg, mnA, alA);
    SLOAD(SO, KVBLK); SLOAD(SE, 2 * KVBLK);
    SWAIT(); SWRITE(1, SO); __syncthreads();
    for (int j = 1; j + 1 < NT; j += 2) {
        SBAR(); qkt(pB0, pB1, K_lds + SHM_K, qr, r32, hi);
        finishSM(pA0, pA1, alA, l_reg, pa0, pa1, pa2, pa3); SBAR();
        SLOAD(SO, (j + 2) * KVBLK); SBAR();
        pv_d0(o, vb0, pa0, pa1, pa2, pa3); partialSM(pB0, pB1, m_reg, mnB, alB);
        __syncthreads(); SWAIT(); SWRITE(0, SE);
        RESC(alB); __syncthreads();
        SBAR(); qkt(pA0, pA1, K_lds, qr, r32, hi);
        finishSM(pB0, pB1, alB, l_reg, pa0, pa1, pa2, pa3); SBAR();
        if (j + 3 < NT) SLOAD(SE, (j + 3) * KVBLK); SBAR();
        pv_d0(o, vb0 + (int)SHM_V, pa0, pa1, pa2, pa3); partialSM(pA0, pA1, m_reg, mnA, alA);
        __syncthreads(); SWAIT(); SWRITE(1, SO);
        RESC(alA); __syncthreads();
    }
    SBAR(); qkt(pB0, pB1, K_lds + SHM_K, qr, r32, hi);
    finishSM(pA0, pA1, alA, l_reg, pa0, pa1, pa2, pa3); SBAR();
    pv_d0(o, vb0, pa0, pa1, pa2, pa3); partialSM(pB0, pB1, m_reg, mnB, alB);
    __syncthreads(); RESC(alB);
    finishSM(pB0, pB1, alB, l_reg, pa0, pa1, pa2, pa3); SBAR();
    pv_d0(o, vb0 + (int)SHM_V, pa0, pa1, pa2, pa3);
    if (hi == 0) li_l[r32] = l_reg; asm volatile("s_waitcnt lgkmcnt(0)" ::: "memory");
    float rli[16];
#pragma unroll
    for (int r = 0; r < 16; ++r) rli[r] = __builtin_amdgcn_rcpf(li_l[crow(r, hi)]);
    bf16_t* Ow = Ob + (long)(wid * QBLK) * LDO;
#pragma unroll
    for (int r = 0; r < 16; ++r) { int orow = crow(r, hi);
#pragma unroll
        for (int d0 = 0; d0 < 4; ++d0) Ow[(long)orow * LDO + d0 * 32 + r32] = (bf16_t)f2bf(o[d0][r] * rli[r]); }
    __syncthreads();
#undef KVP
#undef SLOAD
#undef SWRITE
#undef SWAIT
#undef RESC
}

DI void stage_v128(char* dst, const bf16_t* src, int ld, int tid) {
    const int sr = tid >> 4, sc = (tid & 15) * 8;
    bf16x8 v[4];
#pragma unroll
    for (int i = 0; i < 4; ++i) v[i] = *reinterpret_cast<const bf16x8*>(src + (long)(32 * i + sr) * ld + sc);
#pragma unroll
    for (int i = 0; i < 4; ++i) *(bf16x8*)(dst + (i >> 1) * 16384 + v_st((i & 1) * 32 + sr, sc)) = v[i];
}
DI void stage_k128(char* dst, const bf16_t* src, int ld, int tid) {
    const int sr = tid >> 4, sc = (tid & 15) * 8;
    bf16x8 v[4];
#pragma unroll
    for (int i = 0; i < 4; ++i) v[i] = *reinterpret_cast<const bf16x8*>(src + (long)(32 * i + sr) * ld + sc);
#pragma unroll
    for (int i = 0; i < 4; ++i) *(bf16x8*)(dst + (i >> 1) * 16384 + KSWZ((i & 1) * 32 + sr, sc * 2)) = v[i];
}
DI bf16x8 scale8(bf16x8 a, const float* w) {
    const u32x4 u = __builtin_bit_cast(u32x4, a); u32x4 o;
    o.x = pk2(bflo(u.x) * w[0], bfhi(u.x) * w[1]); o.y = pk2(bflo(u.y) * w[2], bfhi(u.y) * w[3]);
    o.z = pk2(bflo(u.z) * w[4], bfhi(u.z) * w[5]); o.w = pk2(bflo(u.w) * w[6], bfhi(u.w) * w[7]);
    return __builtin_bit_cast(bf16x8, o);
}
DI bf16x8 scale1(bf16x8 a, float s) {
    const u32x4 u = __builtin_bit_cast(u32x4, a); u32x4 o;
    o.x = pk2(bflo(u.x) * s, bfhi(u.x) * s); o.y = pk2(bflo(u.y) * s, bfhi(u.y) * s);
    o.z = pk2(bflo(u.z) * s, bfhi(u.z) * s); o.w = pk2(bflo(u.w) * s, bfhi(u.w) * s);
    return __builtin_bit_cast(bf16x8, o);
}
template <int KS> DI void kv_step(f32x16 (&cf)[2], f32x16 (&cb)[2], int vbK, int vbV, const float* wf, const float* wb, int hi) {
    constexpr int TOFF = (KS >> 2) * 16384, K4 = KS & 3;
    const bf16x8 a = frag<TOFF, 0, K4>(vbK);
    const bf16x8 b0 = frag<32768 + TOFF, 0, K4>(vbV), b1 = frag<32768 + TOFF, 1, K4>(vbV);
    float w8[8];
#pragma unroll
    for (int e = 0; e < 8; ++e) w8[e] = wf[16 * KS + 8 * hi + e];
    const bf16x8 af = scale8(a, w8);
#pragma unroll
    for (int e = 0; e < 8; ++e) w8[e] = wb[16 * KS + 8 * hi + e];
    const bf16x8 ab = scale8(a, w8);
    cf[0] = __builtin_amdgcn_mfma_f32_32x32x16_bf16(af, b0, cf[0], 0, 0, 0); cf[1] = __builtin_amdgcn_mfma_f32_32x32x16_bf16(af, b1, cf[1], 0, 0, 0);
    cb[0] = __builtin_amdgcn_mfma_f32_32x32x16_bf16(ab, b0, cb[0], 0, 0, 0); cb[1] = __builtin_amdgcn_mfma_f32_32x32x16_bf16(ab, b1, cb[1], 0, 0, 0);
}
DI void kv_unit(char* lds, const bf16_t* Ksrc, const bf16_t* Vsrc, bf16_t* KVf, bf16_t* KVb, float lgf2, float lgb2) {
    int tid = threadIdx.x; asm volatile("" : "+v"(tid));
    const int wid = tid >> 6, lane = tid & 63, r32 = lane & 31, hi = lane >> 5;
    float* wf = (float*)(lds + 65536); float* wb = wf + 128;
    stage_v128(lds, Ksrc, 1024, tid); stage_v128(lds + 32768, Vsrc, 1024, tid);
    if (tid < 128) wf[tid] = __builtin_amdgcn_exp2f(lgf2 * (float)(127 - tid)); else if (tid < 256) wb[tid - 128] = __builtin_amdgcn_exp2f(lgb2 * (float)(tid - 128));
    __syncthreads();
    const int db = wid & 3, eh = wid >> 2;
    const int vbK = (int)(uintptr_t)lds + v_rd_base(lane) + db * 512, vbV = (int)(uintptr_t)lds + v_rd_base(lane) + eh * 1024;
    f32x16 cf[2] = {}, cb[2] = {};
    kv_step<0>(cf, cb, vbK, vbV, wf, wb, hi); kv_step<1>(cf, cb, vbK, vbV, wf, wb, hi); kv_step<2>(cf, cb, vbK, vbV, wf, wb, hi); kv_step<3>(cf, cb, vbK, vbV, wf, wb, hi);
    kv_step<4>(cf, cb, vbK, vbV, wf, wb, hi); kv_step<5>(cf, cb, vbK, vbV, wf, wb, hi); kv_step<6>(cf, cb, vbK, vbV, wf, wb, hi); kv_step<7>(cf, cb, vbK, vbV, wf, wb, hi);
#pragma unroll
    for (int eb = 0; eb < 2; ++eb)
#pragma unroll
        for (int r = 0; r < 16; ++r) { const int d = 32 * db + crow(r, hi), e = 64 * eh + 32 * eb + r32;
            KVf[d * 128 + e] = (bf16_t)f2bf(cf[eb][r]); KVb[d * 128 + e] = (bf16_t)f2bf(cb[eb][r]); }
    __syncthreads();
}
template <int TOFF, int KS> DI void cross_step(f32x16* o, int vb, bf16x8 a) {
    const bf16x8 b0 = frag<TOFF, 0, KS>(vb), b1 = frag<TOFF, 1, KS>(vb), b2 = frag<TOFF, 2, KS>(vb), b3 = frag<TOFF, 3, KS>(vb);
    o[0] = __builtin_amdgcn_mfma_f32_32x32x16_bf16(a, b0, o[0], 0, 0, 0); o[1] = __builtin_amdgcn_mfma_f32_32x32x16_bf16(a, b1, o[1], 0, 0, 0);
    o[2] = __builtin_amdgcn_mfma_f32_32x32x16_bf16(a, b2, o[2], 0, 0, 0); o[3] = __builtin_amdgcn_mfma_f32_32x32x16_bf16(a, b3, o[3], 0, 0, 0);
}
DI void cross8(f32x16* o, int vb, const bf16x8* qr, float s) {
    cross_step<0, 0>(o, vb, scale1(qr[0], s)); cross_step<0, 1>(o, vb, scale1(qr[1], s)); cross_step<0, 2>(o, vb, scale1(qr[2], s)); cross_step<0, 3>(o, vb, scale1(qr[3], s));
    cross_step<16384, 0>(o, vb, scale1(qr[4], s)); cross_step<16384, 1>(o, vb, scale1(qr[5], s)); cross_step<16384, 2>(o, vb, scale1(qr[6], s)); cross_step<16384, 3>(o, vb, scale1(qr[7], s));
}
DI void ret_unit(char* lds, const bf16_t* Qb, const bf16_t* Kb, const bf16_t* Vb, const bf16_t* Gb, bf16_t* Yb,
                 const bf16_t* Sf, const bf16_t* Sb, float lgf2, float lgb2) {
    int tid = threadIdx.x; asm volatile("" : "+v"(tid));
    const int wid = tid >> 6, lane = tid & 63, r32 = lane & 31, hi = lane >> 5;
    const int cw = wid >> 2, iw = 32 * (wid & 3) + r32;
    bf16x8 qr[8];
    const bf16_t* Qw = Qb + (long)(wid * QBLK + r32) * 1024 + hi * 8;
#pragma unroll
    for (int d0 = 0; d0 < 8; ++d0) qr[d0] = *reinterpret_cast<const bf16x8*>(Qw + d0 * 16);
    stage_k128(lds, Kb, 1024, tid); stage_k128(lds + 32768, Kb + 128 * 1024, 1024, tid);
    stage_v128(lds + 65536, Vb, 1024, tid); stage_v128(lds + 98304, Vb + 128 * 1024, 1024, tid);
    __syncthreads();
    f32x16 o[4] = {};
    const int vbase = (int)(uintptr_t)lds + v_rd_base(lane);
#pragma unroll
    for (int kt = 0; kt < 2; ++kt) {
        f32x16 p0, p1; bf16x8 pa0, pa1, pa2, pa3;
        qkt(p0, p1, lds + cw * 32768 + kt * 16384, qr, r32, hi);
        int iwv = iw - 64 * kt - 4 * hi; asm volatile("" : "+v"(iwv));
#pragma unroll
        for (int r = 0; r < 16; ++r) {
            const int d0 = iwv - ((r & 3) + 8 * (r >> 2)), d1 = d0 - 32;
            const float f0 = (float)d0, f1 = (float)d1;
            float m0 = __builtin_amdgcn_exp2f(d0 > 0 ? lgf2 * f0 : -lgb2 * f0), m1 = __builtin_amdgcn_exp2f(d1 > 0 ? lgf2 * f1 : -lgb2 * f1);
            m0 = d0 == 0 ? 2.f : m0; m1 = d1 == 0 ? 2.f : m1;
            p0[r] *= m0; p1[r] *= m1;
        }
        packP(p0, p1, pa0, pa1, pa2, pa3); SBAR();
        pv_d0(o, vbase + 65536 + cw * 32768 + kt * 16384, pa0, pa1, pa2, pa3);
    }
    __syncthreads();
    stage_v128(lds, Sf, 128, tid); stage_v128(lds + 32768, Sf + 16384, 128, tid);
    stage_v128(lds + 65536, Sb, 128, tid); stage_v128(lds + 98304, Sb + 16384, 128, tid);
    __syncthreads();
    cross8(o, vbase + cw * 32768, qr, __builtin_amdgcn_exp2f(lgf2 * (float)(iw + 1)));
    cross8(o, vbase + 65536 + cw * 32768, qr, __builtin_amdgcn_exp2f(lgb2 * (float)(128 - iw)));
    __syncthreads();
    char* st = lds + wid * 8192;
#pragma unroll
    for (int r = 0; r < 16; ++r) {
        float s = o[0][r] * o[0][r] + o[1][r] * o[1][r] + o[2][r] * o[2][r] + o[3][r] * o[3][r];
        s += __shfl_xor(s, 1); s += __shfl_xor(s, 2); s += __shfl_xor(s, 4); s += __shfl_xor(s, 8); s += __shfl_xor(s, 16);
        const float rstd = rsqrtf(s * (1.f / 128.f) + NEPS);
        const int orow = crow(r, hi);
#pragma unroll
        for (int d0 = 0; d0 < 4; ++d0) *(bf16_t*)(st + orow * 256 + (d0 * 32 + r32) * 2) = (bf16_t)f2bf(o[d0][r] * rstd);
    }
    LDS_WAIT();
    const bf16_t* Gw = Gb + (long)(wid * QBLK) * 1024; bf16_t* Yw = Yb + (long)(wid * QBLK) * 1024;
#pragma unroll 2
    for (int i = 0; i < 8; ++i) {
        const int c = i * 64 + lane, row = c >> 4, col8 = (c & 15) * 8;
        const u32x4 y = *(const u32x4*)(st + row * 256 + col8 * 2); const u32x4 g = *(const u32x4*)(Gw + (long)row * 1024 + col8); u32x4 w;
        w.x = pk2(siluf_(bflo(g.x)) * bflo(y.x), siluf_(bfhi(g.x)) * bfhi(y.x)); w.y = pk2(siluf_(bflo(g.y)) * bflo(y.y), siluf_(bfhi(g.y)) * bfhi(y.y));
        w.z = pk2(siluf_(bflo(g.z)) * bflo(y.z), siluf_(bfhi(g.z)) * bfhi(y.z)); w.w = pk2(siluf_(bflo(g.w)) * bflo(y.w), siluf_(bfhi(g.w)) * bfhi(y.w));
        *(u32x4*)(Yw + (long)row * 1024 + col8) = w;
    }
    __syncthreads();
}
}

DI void transpose_item(const float* W, int N, bf16_t* WT, int K, int k0, int n0, int drow0, float* scr, int lane) {
#pragma unroll 8
    for (int i = 0; i < 32; ++i) { const int kk = 2 * i + (lane >> 5); scr[kk * 33 + (lane & 31)] = W[(size_t)(k0 + kk) * N + n0 + (lane & 31)]; }
    LDS_WAIT();
    const int c = lane & 7;
#pragma unroll
    for (int j = 0; j < 4; ++j) { const int n = (lane >> 3) + 8 * j; const float* s = scr + (8 * c) * 33 + n;
        u32x4 o; o.x = pk2(s[0 * 33], s[1 * 33]); o.y = pk2(s[2 * 33], s[3 * 33]); o.z = pk2(s[4 * 33], s[5 * 33]); o.w = pk2(s[6 * 33], s[7 * 33]);
        *(u32x4*)(WT + (size_t)(drow0 + n) * K + k0 + 8 * c) = o; }
    LDS_WAIT();
}
DI int swiglu_row(int n0) { return n0 < DFF ? 256 * (n0 >> 7) + (n0 & 127) : 256 * ((n0 - DFF) >> 7) + 128 + ((n0 - DFF) & 127); }

DI void norm_rows(const float* srcx, const float* srcc, const float* mod, int ish, int isc, bf16_t* dst, int nrows, int gw, int NGW, int lane) {
    for (int r = gw; r < nrows; r += NGW) {
        const float* src; int bidx;
        if (r < TX) { src = srcx + (size_t)r * DM; bidx = r >> 13; } else { src = srcc + (size_t)(r - TX) * DM; bidx = 4; }
        const float* sh = mod + (size_t)bidx * NMODW + ish * DM; const float* sc = mod + (size_t)bidx * NMODW + isc * DM;
        f32x4 v[8]; float ss = 0.f;
#pragma unroll
        for (int j = 0; j < 8; ++j) { v[j] = ((const f32x4*)src)[lane + 64 * j]; ss += v[j].x * v[j].x + v[j].y * v[j].y + v[j].z * v[j].z + v[j].w * v[j].w; }
        const float rstd = rsqrtf(wave_sum(ss) * (1.f / DM) + NEPS);
#pragma unroll
        for (int j = 0; j < 8; ++j) { const int col = 4 * lane + 256 * j; const f32x4 s4 = *(const f32x4*)(sc + col), h4 = *(const f32x4*)(sh + col);
            const f32x4 o = v[j] * rstd * (s4 + 1.f) + h4; u32x2 w; w.x = pk2(o.x, o.y); w.y = pk2(o.z, o.w);
            *(u32x2*)(dst + (size_t)r * DM + col) = w; }
    }
}


#define LASQ __attribute__((address_space(3)))
#define XB_TMO      128
#define XB_XCNT(j)  (256  + 64 * (j))
#define XB_XSUB(j)  (1280 + 64 * (j))
#define XB_XGEN(j)  (2304 + 64 * (j))
#define XB_TOP      3328
#define XB_TOPGEN   3392
#define XCD_BAR_WORDS 3456
#define XB_SPIN_CAP (1u << 18)
__device__ __forceinline__ unsigned xb_ld(unsigned* p)              { return __hip_atomic_load(p, __ATOMIC_RELAXED, __HIP_MEMORY_SCOPE_AGENT); }
__device__ __forceinline__ unsigned xb_add(unsigned* p, unsigned v) { return __hip_atomic_fetch_add(p, v, __ATOMIC_RELAXED, __HIP_MEMORY_SCOPE_AGENT); }
__device__ __forceinline__ unsigned xb_xcc_id() { return (unsigned)__builtin_amdgcn_s_getreg((3 << 11) | 20) & 0xFu; }
#define XB_SPIN(cond, bar) do { unsigned _sp = 0; while (cond) { __builtin_amdgcn_s_sleep(1); \
    if ((++_sp & 255u) == 0u) { if (xb_ld(&(bar)[XB_TMO])) break; if (_sp > XB_SPIN_CAP) { atomicAdd(&(bar)[XB_TMO], 1u); break; } } } } while (0)
struct XcdBarrier { unsigned* bar; unsigned x; volatile LASQ unsigned* st; };
__device__ __forceinline__ XcdBarrier xcd_barrier_post(unsigned* bar, volatile LASQ unsigned* st) {
    XcdBarrier b; b.bar = bar; b.x = xb_xcc_id(); b.st = st;
    if (threadIdx.x == 0) (void)xb_add(&bar[XB_XCNT(b.x)], 1u);
    return b;
}
__device__ __forceinline__ void xcd_barrier_complete(unsigned* bar, unsigned x, unsigned& nloc, unsigned& nx) {
    const unsigned G = gridDim.x * gridDim.y * gridDim.z;
    unsigned sum, cnt, mine, sp = 0u;
    for (;;) {
        sum = 0u; cnt = 0u; mine = 0u;
#pragma unroll
        for (unsigned j = 0; j < 16; ++j) { const unsigned c = xb_ld(&bar[XB_XCNT(j)]); sum += c; cnt += (c > 0u) ? 1u : 0u; mine = (j == x) ? c : mine; }
        if (sum == G) break;
        __builtin_amdgcn_s_sleep(1);
        if ((++sp & 255u) == 0u) { if (xb_ld(&bar[XB_TMO])) break; if (sp > XB_SPIN_CAP) { atomicAdd(&bar[XB_TMO], 1u); break; } }
    }
    nloc = mine > 0u ? mine : 1u; nx = cnt > 0u ? cnt : 1u;
}
__device__ __forceinline__ void xcd_barrier(const XcdBarrier& b) {
    asm volatile("s_waitcnt vmcnt(0)" ::: "memory");
    __syncthreads();
    if (threadIdx.x == 0) {
        unsigned* bar = b.bar;
        __builtin_amdgcn_s_waitcnt(0);
        unsigned nloc = b.st[0], nx = b.st[1];
        if (nloc == 0u) { xcd_barrier_complete(bar, b.x, nloc, nx); b.st[0] = nloc; b.st[1] = nx; }
        const unsigned old = xb_add(&bar[XB_XSUB(b.x)], 1u);
        const unsigned gen = old / nloc;
        if (old + 1u == (gen + 1u) * nloc) {
            __builtin_amdgcn_fence(__ATOMIC_RELEASE, "agent");
            asm volatile("s_waitcnt vmcnt(0)" ::: "memory");
            const unsigned og = xb_add(&bar[XB_TOP], 1u);
            const unsigned tg = og / nx;
            if (og + 1u == (tg + 1u) * nx) xb_add(&bar[XB_TOPGEN], 1u);
            else XB_SPIN(xb_ld(&bar[XB_TOPGEN]) == tg, bar);
            __builtin_amdgcn_fence(__ATOMIC_ACQUIRE, "agent");
            xb_add(&bar[XB_XGEN(b.x)], 1u);
            asm volatile("s_waitcnt vmcnt(0)" ::: "memory");
        } else {
            XB_SPIN(xb_ld(&bar[XB_XGEN(b.x)]) == gen, bar);
            __builtin_amdgcn_fence(__ATOMIC_ACQUIRE, "agent");
            asm volatile("s_waitcnt vmcnt(0)" ::: "memory");
        }
    }
    __syncthreads();
}


constexpr int TI1 = 32 * 352, TI2 = 88 * 64, TIIN = 32 * 304, TIPA = 16 * 64, TIO = 32 * 64;
constexpr int NIT = 2 * TI1 + 2 * TI2 + TIIN + 2 * TIPA + TIO;
constexpr int DEF_P2 = 9, DEF_P3 = 5, DEF_P5 = 9;
constexpr int NDEF_P2 = 80 * 8 * DEF_P2, NDEF_P3 = 128 * 8 * DEF_P3, NDEF_P5 = 104 * 8 * DEF_P5;
constexpr int NIT_P0 = NIT - NDEF_P2 - NDEF_P3 - NDEF_P5;
static_assert(NIT_P0 >= TI1 + TI2 + TIIN + 2 * TIPA, "deferred transposes must not include W1, W2, WIN, WPA, WPR (needed before the last tail)");
#define TRANSPOSE_ITEM(IT, LANE, WAVE) do { int r_ = (IT); float* scr_ = (float*)(lds + (WAVE) * 16384); \
    if (r_ < TI1) { const int kb = r_ / 352, nb = r_ % 352; transpose_item(a.in[6], 2 * DFF, W1, DM, 64 * kb, 32 * nb, swiglu_row(32 * nb), scr_, (LANE)); break; } r_ -= TI1; \
    if (r_ < TI2) { const int kb = r_ / 64, nb = r_ % 64; transpose_item(a.in[7], DM, W2, DFF, 64 * kb, 32 * nb, 32 * nb, scr_, (LANE)); break; } r_ -= TI2; \
    if (r_ < TIIN) { const int kb = r_ / 304, nb = r_ % 304; transpose_item(a.in[8], PW, WIN, DM, 64 * kb, 32 * nb, 32 * nb, scr_, (LANE)); break; } r_ -= TIIN; \
    if (r_ < TIPA) { const int kb = r_ / 64, nb = r_ % 64; transpose_item(a.in[12], DM, WPA, 1024, 64 * kb, 32 * nb, 32 * nb, scr_, (LANE)); break; } r_ -= TIPA; \
    if (r_ < TIPA) { const int kb = r_ / 64, nb = r_ % 64; transpose_item(a.in[13], DM, WPR, 1024, 64 * kb, 32 * nb, 32 * nb, scr_, (LANE)); break; } r_ -= TIPA; \
    if (r_ < TIO) { const int kb = r_ / 64, nb = r_ % 64; transpose_item(a.in[14], DM, WO, DM, 64 * kb, 32 * nb, 32 * nb, scr_, (LANE)); break; } r_ -= TIO; \
    if (r_ < TI1) { const int kb = r_ / 352, nb = r_ % 352; transpose_item(a.in[15], 2 * DFF, W3, DM, 64 * kb, 32 * nb, swiglu_row(32 * nb), scr_, (LANE)); break; } r_ -= TI1; \
    { const int kb = r_ / 64, nb = r_ % 64; transpose_item(a.in[16], DM, W4, DFF, 64 * kb, 32 * nb, 32 * nb, scr_, (LANE)); } } while (0)
#define DEFERRED_TRANSPOSES(FIRST, CNT, BASE) do { if (G == 256 && bid >= (FIRST)) { int t_ = threadIdx.x; asm volatile("" : "+v"(t_)); \
    const int lane_ = t_ & 63, wave_ = __builtin_amdgcn_readfirstlane(t_ >> 6), k0_ = ((bid - (FIRST)) * 8 + wave_) * (CNT); \
    _Pragma("unroll 1") for (int q_ = 0; q_ < (CNT); ++q_) { TRANSPOSE_ITEM(NIT_P0 + (BASE) + k0_ + q_, lane_, wave_); } } } while (0)

#ifndef PHMASK
#define PHMASK 0xFFFF
#endif
struct Args { const float* in[18]; float* out; unsigned char* ws; };

__global__ void __launch_bounds__(512, 2) mega_fwd(Args a) {
    extern __shared__ __attribute__((aligned(16))) unsigned char lds[];
    cg::grid_group grid = cg::this_grid();
    const int tid = threadIdx.x, lane = tid & 63, wave = __builtin_amdgcn_readfirstlane(tid >> 6);
    const int G = gridDim.x, bid = blockIdx.x;
    const int gw = bid * 8 + wave, NGW = G * 8;
    unsigned char* ws = a.ws;
    const float* x = a.in[0]; const float* cvec = a.in[1]; const float* ctx = a.in[2]; const float* cctx = a.in[3];
    const float* w_ada = a.in[4]; const float* b_ada = a.in[5];
    float* mod = (float*)(ws + WS_MOD);
    bf16_t* W1 = (bf16_t*)(ws + WS_W1); bf16_t* W2 = (bf16_t*)(ws + WS_W2); bf16_t* WIN = (bf16_t*)(ws + WS_WIN); bf16_t* WPA = (bf16_t*)(ws + WS_WPA);
    bf16_t* WPR = (bf16_t*)(ws + WS_WPR); bf16_t* WO = (bf16_t*)(ws + WS_WO); bf16_t* W3 = (bf16_t*)(ws + WS_W3); bf16_t* W4 = (bf16_t*)(ws + WS_W4);
    bf16_t* XN = (bf16_t*)(ws + WS_XN); bf16_t* HID = (bf16_t*)(ws + WS_R);
    PG8_LAS unsigned char* ldsl = (PG8_LAS unsigned char*)lds;

    unsigned* barw = (unsigned*)(ws + WS_MOD + 640 * 1024);
    volatile LASQ unsigned* bst = (volatile LASQ unsigned*)((LASQ unsigned char*)lds + LDS_BYTES - 64);
    if (bid == 0) for (int i = tid; i < XCD_BAR_WORDS; i += 512) barw[i] = 0u;
    if (tid < 2) bst[tid] = 0u;
    __syncthreads();
    if constexpr ((PHMASK >> 0) & 1) {
    if (bid < 72) {
        float* sc = (float*)lds; float* red = (float*)(lds + 40960);
        for (int i = tid; i < 5 * DM; i += 512) { const int c = i / DM, k = i % DM; const float v = c < 4 ? cvec[c * DM + k] : cctx[k]; sc[i] = v / (1.f + __expf(-v)); }
        __syncthreads();
        const int n0 = bid * 256 + lane * 4;
        float acc[5][4];
#pragma unroll
        for (int c = 0; c < 5; ++c)
#pragma unroll
            for (int j = 0; j < 4; ++j) acc[c][j] = 0.f;
#pragma unroll 8
        for (int k = wave * 256; k < wave * 256 + 256; ++k) { const f32x4 w = *(const f32x4*)(w_ada + (size_t)k * NMODW + n0);
#pragma unroll
            for (int c = 0; c < 5; ++c) { const float s = sc[c * DM + k]; acc[c][0] += s * w.x; acc[c][1] += s * w.y; acc[c][2] += s * w.z; acc[c][3] += s * w.w; } }
#pragma unroll
        for (int c = 0; c < 5; ++c)
#pragma unroll
            for (int j = 0; j < 4; ++j) red[(wave * 5 + c) * 256 + lane * 4 + j] = acc[c][j];
        __syncthreads();
        for (int i = tid; i < 5 * 256; i += 512) { const int c = i >> 8, n = i & 255; float s = 0.f;
#pragma unroll
            for (int w = 0; w < 8; ++w) s += red[(w * 5 + c) * 256 + n];
            mod[(size_t)c * NMODW + bid * 256 + n] = s + b_ada[bid * 256 + n]; }
        __syncthreads();
    }
    {
        float* scr = (float*)(lds + wave * 16384);
        const int nslot = (G > 72) ? 576 + (G - 72) * 16 : NGW;
        const int slot0 = (G > 72 && bid >= 72) ? 576 + ((bid - 72) * 8 + wave) * 2 : gw, nown = (G > 72 && bid >= 72) ? 2 : 1;
        const int nit0 = (G == 256) ? NIT_P0 : NIT;
        for (int so = 0; so < nown; ++so)
        for (int it = slot0 + so; it < nit0; it += nslot) { TRANSPOSE_ITEM(it, lane, wave); }
    }
    }
    grid.sync();
    XcdBarrier xb = xcd_barrier_post(barw, bst);

    if constexpr ((PHMASK >> 1) & 1) {
    norm_rows(x, ctx, mod, 0, 1, XN, TT, gw, NGW, lane);
    }
    xcd_barrier(xb);

    if constexpr ((PHMASK >> 2) & 1) {
    { pg8::Gemm g{XN, W1, TT, 2 * DFF, DM}; pg8::StaticOrder S; S.init(TT, 2 * DFF, DM, G, bid); pg8::EpiSwiglu E{HID};
      pg8::gemm_phase<pg8::EpiSwiglu, pg8::StaticOrder>(ldsl, g, S, E); }
    DEFERRED_TRANSPOSES(176, DEF_P2, 0);
    }
    xcd_barrier(xb);

    if constexpr ((PHMASK >> 3) & 1) {
    { pg8::Gemm g{HID, W2, TT, DM, DFF}; pg8::OrderDown1 S; S.init(G, bid); pg8::EpiResid E{x, ctx, a.out, (float*)(ws + WS_PART), mod + 2 * DM, 0.5f};
      pg8::gemm_phase<pg8::EpiResid, pg8::OrderDown1>(ldsl, g, S, E); }
    DEFERRED_TRANSPOSES(128, DEF_P3, NDEF_P2);
    }
    xcd_barrier(xb);

    if constexpr ((PHMASK >> 4) & 1) {
    norm_rows(a.out, a.out, mod, 3, 4, XN, TX, gw, NGW, lane);
    {
        const float* part = (const float*)(ws + WS_PART); const float* g1 = mod + (size_t)4 * NMODW + 2 * DM; const float* sh = mod + (size_t)4 * NMODW + 3 * DM; const float* sc = mod + (size_t)4 * NMODW + 4 * DM;
        for (int r = NGW - 1 - gw; r < TC; r += NGW) {
            f32x4 v[8]; float ss = 0.f;
#pragma unroll
            for (int j = 0; j < 8; ++j) { const size_t o = (size_t)r * DM + 4 * lane + 256 * j;
                const f32x4 p = (*(const f32x4*)(part + o) + *(const f32x4*)(part + (size_t)TC * DM + o)) + (*(const f32x4*)(part + (size_t)2 * TC * DM + o) + *(const f32x4*)(part + (size_t)3 * TC * DM + o));
                v[j] = *(const f32x4*)(ctx + o) + *(const f32x4*)(g1 + 4 * lane + 256 * j) * 0.5f * p;
                ss += v[j].x * v[j].x + v[j].y * v[j].y + v[j].z * v[j].z + v[j].w * v[j].w; }
            const float rstd = rsqrtf(wave_sum(ss) * (1.f / DM) + NEPS);
#pragma unroll
            for (int j = 0; j < 8; ++j) { const int col = 4 * lane + 256 * j; const f32x4 s4 = *(const f32x4*)(sc + col), h4 = *(const f32x4*)(sh + col);
                const f32x4 o = v[j] * rstd * (s4 + 1.f) + h4; u32x2 w; w.x = pk2(o.x, o.y); w.y = pk2(o.z, o.w);
                *(u32x2*)(XN + (size_t)(TX + r) * DM + col) = w; }
        }
    }
    }
    xcd_barrier(xb);

    if constexpr ((PHMASK >> 5) & 1) {
    { pg8::Gemm g{XN, WIN, TT, PW, DM}; pg8::StaticOrder S; S.init(TT, PW, DM, G, bid); pg8::EpiProj E{ws};
      pg8::gemm_phase<pg8::EpiProj, pg8::StaticOrder>(ldsl, g, S, E); }
    DEFERRED_TRANSPOSES(152, DEF_P5, NDEF_P2 + NDEF_P3);
    }
    xcd_barrier(xb);

    bf16_t* QA = (bf16_t*)(ws + WS_QA); bf16_t* KA = (bf16_t*)(ws + WS_KA); bf16_t* VA = (bf16_t*)(ws + WS_VA); bf16_t* QR = (bf16_t*)(ws + WS_QR);
    bf16_t* KR = (bf16_t*)(ws + WS_KR); bf16_t* VR = (bf16_t*)(ws + WS_VR); bf16_t* GR = (bf16_t*)(ws + WS_GR); bf16_t* GA = (bf16_t*)(ws + WS_GA); bf16_t* GB = (bf16_t*)(ws + WS_GB);
    bf16_t* KVF = (bf16_t*)(ws + WS_KVF); bf16_t* KVB = (bf16_t*)(ws + WS_KVB);
    const float* dlog = a.in[11];
    constexpr float LOG2E = 1.4426950408889634f;

    if constexpr ((PHMASK >> 6) & 1) {
    {
        const float* qg = a.in[9]; const float* kg = a.in[10];
        f32x2_t* tab = (f32x2_t*)(lds + 69632);
        for (int i = tid; i < 128 * 32; i += 512) { const float invf = exp2f(-(float)(2 * (i & 31)) * (13.287712379549449f / 64.f)); float sn, cs; sincosf((float)(i >> 5) * invf, &sn, &cs); tab[i] = (f32x2_t){cs, sn}; }
        __syncthreads();
        float qgl[16], kgl[4];
#pragma unroll
        for (int i = 0; i < 16; ++i) qgl[i] = qg[(lane & 7) * 16 + i];
#pragma unroll
        for (int i = 0; i < 4; ++i) kgl[i] = kg[(lane & 31) * 4 + i];
        const bool qrowpos = (lane & 7) < 4, krowpos = (lane & 31) < 16;
        const int qf0 = ((lane & 7) * 8) & 31, kf0 = ((lane & 31) * 2) & 31;
        for (int r = gw; r < TT; r += NGW) {
            const bool isx = r < TX;
            u32x2* kp = (u32x2*)(KA + (size_t)r * 256) + lane; const u32x2 kw = *kp;
            u32x4* qp = (u32x4*)(QA + (size_t)r * 1024) + 2 * lane; u32x4 q0 = {0, 0, 0, 0}, q1 = {0, 0, 0, 0};
            if (isx) { q0 = qp[0]; q1 = qp[1]; }
            const int t = r & (SEQ - 1), prow = t >> 6, pcol = t & 63;
            {
                float xv[4] = {bflo(kw.x), bfhi(kw.x), bflo(kw.y), bfhi(kw.y)};
                float ss = xv[0] * xv[0] + xv[1] * xv[1] + xv[2] * xv[2] + xv[3] * xv[3];
                ss += __shfl_xor(ss, 1); ss += __shfl_xor(ss, 2); ss += __shfl_xor(ss, 4); ss += __shfl_xor(ss, 8); ss += __shfl_xor(ss, 16);
                const float rstd = rsqrtf(ss * (1.f / 128.f) + NEPS);
                unsigned ow[2];
#pragma unroll
                for (int p = 0; p < 2; ++p) { f32x2_t c = {1.f, 0.f}; if (isx) c = tab[(krowpos ? prow : pcol) * 32 + kf0 + p];
                    const float x0 = xv[2 * p] * rstd * kgl[2 * p], x1 = xv[2 * p + 1] * rstd * kgl[2 * p + 1]; ow[p] = pk2(x0 * c.x - x1 * c.y, x0 * c.y + x1 * c.x); }
                u32x2 o; o.x = ow[0]; o.y = ow[1]; *kp = o;
            }
            if (isx) {
                const unsigned qw[8] = {q0.x, q0.y, q0.z, q0.w, q1.x, q1.y, q1.z, q1.w};
                float ss = 0.f;
#pragma unroll
                for (int p = 0; p < 8; ++p) ss += bflo(qw[p]) * bflo(qw[p]) + bfhi(qw[p]) * bfhi(qw[p]);
                ss += __shfl_xor(ss, 1); ss += __shfl_xor(ss, 2); ss += __shfl_xor(ss, 4);
                const float rstd = rsqrtf(ss * (1.f / 128.f) + NEPS);
                const f32x2_t* tp = tab + (qrowpos ? prow : pcol) * 32 + qf0;
                unsigned ow[8];
#pragma unroll
                for (int p = 0; p < 8; ++p) { const f32x2_t c = tp[p]; const float x0 = bflo(qw[p]) * rstd * qgl[2 * p], x1 = bfhi(qw[p]) * rstd * qgl[2 * p + 1]; ow[p] = pk2(x0 * c.x - x1 * c.y, x0 * c.y + x1 * c.x); }
                u32x4 o0 = {ow[0], ow[1], ow[2], ow[3]}, o1 = {ow[4], ow[5], ow[6], ow[7]}; qp[0] = o0; qp[1] = o1;
            }
        }
        __syncthreads();
        for (int u = bid; u < NB * 8 * NEC; u += G) {
            const int e = u % NEC, bh = u / NEC, b = bh >> 3, h = bh & 7;
            const size_t row0 = e < 2 ? (size_t)TX + b * CTX + e * 128 : (size_t)b * SEQ + (e - 2) * 128;
            const float lf = dlog[h], lb = dlog[8 + h];
            const float lgf2 = -log1pf(expf(-lf)) * LOG2E, lgb2 = -log1pf(expf(-lb)) * LOG2E;
            att::kv_unit((char*)lds, KR + row0 * 1024 + h * 128, VR + row0 * 1024 + h * 128, KVF + ((size_t)bh * NEC + e) * 16384, KVB + ((size_t)bh * NEC + e) * 16384, lgf2, lgb2);
        }
    }
    }
    xcd_barrier(xb);

    if constexpr ((PHMASK >> 7) & 1) {
    for (int task = bid * 512 + tid; task < 64 * 2048; task += G * 512) {
        const int el = (task & 2047) * 8, bhd = task >> 11, dir = bhd & 1, bh = bhd >> 1, h = bh & 7;
        const float lg = dlog[dir * 8 + h]; const float cd = exp2f(128.f * (-log1pf(expf(-lg)) * LOG2E));
        bf16_t* base = (dir ? KVB : KVF) + (size_t)bh * NEC * 16384 + el;
        float S[8];
#pragma unroll
        for (int i = 0; i < 8; ++i) S[i] = 0.f;
        auto ord = [&](int q) { return dir ? (q == 0 ? 1 : q == 1 ? 0 : NEC + 1 - q) : q; };
        for (int s0 = 0; s0 < NEC; s0 += 6) {
            u32x4 cv[6];
#pragma unroll
            for (int i = 0; i < 6; ++i) cv[i] = *(const u32x4*)(base + (size_t)ord(s0 + i) * 16384);
#pragma unroll
            for (int i = 0; i < 6; ++i) {
                const u32x4 cur = cv[i];
                u32x4 o; o.x = pk2(S[0], S[1]); o.y = pk2(S[2], S[3]); o.z = pk2(S[4], S[5]); o.w = pk2(S[6], S[7]);
                *(u32x4*)(base + (size_t)ord(s0 + i) * 16384) = o;
                S[0] = cd * S[0] + bflo(cur.x); S[1] = cd * S[1] + bfhi(cur.x); S[2] = cd * S[2] + bflo(cur.y); S[3] = cd * S[3] + bfhi(cur.y);
                S[4] = cd * S[4] + bflo(cur.z); S[5] = cd * S[5] + bfhi(cur.z); S[6] = cd * S[6] + bflo(cur.w); S[7] = cd * S[7] + bfhi(cur.w);
            }
        }
    }
    }
    xcd_barrier(xb);

    if constexpr ((PHMASK >> 8) & 1) {
#pragma unroll 1
    for (int pass = 0; pass < 2; ++pass) {
    const bool do_ret = (pass == 0) != (((bid >> 3) & 1) != 0);
    if (do_ret)
    for (int u = bid; u < NB * 8 * 32; u += G) {
        const int blk = u & 31, bh = u >> 5, b = bh >> 3, h = bh & 7;
        const size_t row0 = (size_t)b * SEQ + blk * 256;
        const float lf = dlog[h], lb = dlog[8 + h];
        const float lgf2 = -log1pf(expf(-lf)) * LOG2E, lgb2 = -log1pf(expf(-lb)) * LOG2E;
        const size_t so = ((size_t)bh * NEC + 2 + 2 * blk) * 16384;
        att::ret_unit((char*)lds, QR + row0 * 1024 + h * 128, KR + row0 * 1024 + h * 128, VR + row0 * 1024 + h * 128, GR + row0 * 1024 + h * 128, QR + row0 * 1024 + h * 128,
                      KVF + so, KVB + so, lgf2, lgb2);
    }
    else
    for (int u = bid; u < NB * 8 * 32; u += G) {
        const int xc = u & 7, rest = u >> 3, g = rest >> 5, qb = rest & 31, b = xc >> 1, kvh = xc & 1, hq = kvh * 4 + g;
        const size_t qrow = (size_t)b * SEQ + qb * 256;
        att::attn_unit(QA + qrow * 1024 + hq * 128, KA + ((size_t)TX + b * CTX) * 256 + kvh * 128, KA + (size_t)b * SEQ * 256 + kvh * 128,
                       VA + ((size_t)TX + b * CTX) * 256 + kvh * 128, VA + (size_t)b * SEQ * 256 + kvh * 128, QA + qrow * 1024 + hq * 128, (char*)lds);
    }
    }
    }
    xcd_barrier(xb);

    if constexpr ((PHMASK >> 9) & 1) {
    { pg8::Gemm g{QA, WPA, TX, DM, 1024}; pg8::StaticOrder S; S.init(TX, DM, 1024, G, bid); pg8::EpiMerge<0> E{GA, GB};
      pg8::gemm_phase<pg8::EpiMerge<0>, pg8::StaticOrder>(ldsl, g, S, E); }
    { pg8::Gemm g{QR, WPR, TX, DM, 1024}; pg8::StaticOrder S; S.init(TX, DM, 1024, G, bid); pg8::EpiMerge<1> E{GA, GB};
      pg8::gemm_phase<pg8::EpiMerge<1>, pg8::StaticOrder>(ldsl, g, S, E); }
    }
    xcd_barrier(xb);

    if constexpr ((PHMASK >> 10) & 1) {
    { pg8::Gemm g{GA, WO, TX, DM, DM}; pg8::StaticOrder S; S.init(TX, DM, DM, G, bid); pg8::EpiResid E{a.out, a.out, a.out, a.out, mod + 5 * DM, 1.0f};
      pg8::gemm_phase<pg8::EpiResid, pg8::StaticOrder>(ldsl, g, S, E); }
    }
    xcd_barrier(xb);

    if constexpr ((PHMASK >> 11) & 1) {
    norm_rows(a.out, a.out, mod, 6, 7, XN, TX, gw, NGW, lane);
    }
    xcd_barrier(xb);

    if constexpr ((PHMASK >> 12) & 1) {
    { pg8::Gemm g{XN, W3, TX, 2 * DFF, DM}; pg8::StaticOrder S; S.init(TX, 2 * DFF, DM, G, bid); pg8::EpiSwiglu E{HID};
      pg8::gemm_phase<pg8::EpiSwiglu, pg8::StaticOrder>(ldsl, g, S, E); }
    }
    xcd_barrier(xb);

    if constexpr ((PHMASK >> 13) & 1) {
    { pg8::Gemm g{HID, W4, TX, DM, DFF}; pg8::StaticOrder S; S.init(TX, DM, DFF, G, bid); pg8::EpiResid E{a.out, a.out, a.out, a.out, mod + 8 * DM, 0.5f};
      pg8::gemm_phase<pg8::EpiResid, pg8::StaticOrder>(ldsl, g, S, E); }
    }
    xcd_barrier(xb);

    if constexpr ((PHMASK >> 14) & 1) {
    {
        const float* fn = a.in[17];
        for (int r = gw; r < TX; r += NGW) {
            float* row = a.out + (size_t)r * DM; f32x4 v[8]; float ss = 0.f;
#pragma unroll
            for (int j = 0; j < 8; ++j) { v[j] = ((const f32x4*)row)[lane + 64 * j]; ss += v[j].x * v[j].x + v[j].y * v[j].y + v[j].z * v[j].z + v[j].w * v[j].w; }
            const float rstd = rsqrtf(wave_sum(ss) * (1.f / DM) + NEPS);
#pragma unroll
            for (int j = 0; j < 8; ++j) { const f32x4 f4 = ((const f32x4*)fn)[lane + 64 * j]; ((f32x4*)row)[lane + 64 * j] = v[j] * rstd * f4; }
        }
    }
    }
}

extern "C" void kernel_launch(void* const* d_in, const int* in_sizes, int n_in, void* d_out, int out_size, void* d_ws, size_t ws_size, hipStream_t stream) {
    static int grid = 0;
    if (grid == 0) {
        int dev = 0, cus = 0, per_cu = 0;
        (void)hipGetDevice(&dev);
        (void)hipDeviceGetAttribute(&cus, hipDeviceAttributeMultiprocessorCount, dev);
        if (hipFuncSetAttribute((const void*)mega_fwd, hipFuncAttributeMaxDynamicSharedMemorySize, LDS_BYTES) != hipSuccess) fprintf(stderr, "kernel_launch: hipFuncSetAttribute failed\n");
        (void)hipOccupancyMaxActiveBlocksPerMultiprocessor(&per_cu, (const void*)mega_fwd, 512, LDS_BYTES);
        if (ws_size < WS_END || n_in != 18) { fprintf(stderr, "kernel_launch: workspace %zu < %zu or n_in %d != 18\n", ws_size, (size_t)WS_END, n_in); grid = -1; return; }
        if (per_cu < 1) fprintf(stderr, "kernel_launch: occupancy query says %d blocks per CU\n", per_cu);
        grid = cus > 0 ? cus : 256;
    }
    if (grid < 0) return;
    Args a{};
    for (int i = 0; i < 18; ++i) a.in[i] = (const float*)d_in[i];
    a.out = (float*)d_out; a.ws = (unsigned char*)d_ws;
    void* args[] = {&a};
    hipError_t e = hipLaunchCooperativeKernel((const void*)mega_fwd, dim3(grid), dim3(512), args, LDS_BYTES, stream);
    if (e != hipSuccess) fprintf(stderr, "kernel_launch: cooperative launch failed: %s (grid %d)\n", hipGetErrorString(e), grid);
}
```

```cpp
#include <hip/hip_runtime.h>
#include <hip/hip_cooperative_groups.h>
#include <cstdio>
#include <cstdint>
namespace cg = cooperative_groups;

constexpr int NB = 4, SEQ = 8192, DM = 2048, CTX = 256, TX = NB * SEQ, TC = NB * CTX, TT = TX + TC;
constexpr int DFF = 5632, PW = 9728, NMODW = 9 * DM;
constexpr int NCH = SEQ / 128, NEC = NCH + 2;
constexpr float NEPS = 1e-6f;

typedef unsigned short bf16_t;
typedef short bf16x8 __attribute__((ext_vector_type(8)));
typedef short s16x4 __attribute__((ext_vector_type(4)));
typedef float f32x4 __attribute__((ext_vector_type(4)));
typedef float f32x16 __attribute__((ext_vector_type(16)));
typedef unsigned u32x4 __attribute__((ext_vector_type(4)));
typedef unsigned u32x2 __attribute__((ext_vector_type(2)));
typedef float f32x2_t __attribute__((ext_vector_type(2)));
typedef __bf16 bf16x2_t __attribute__((ext_vector_type(2)));

constexpr size_t MiB = 1u << 20;
constexpr size_t WS_MOD = 0;
constexpr size_t WS_HC = 1 * MiB;
constexpr size_t WS_W1 = 9 * MiB;
constexpr size_t WS_W2 = 53 * MiB;
constexpr size_t WS_WIN = 75 * MiB;
constexpr size_t WS_WPA = 113 * MiB;
constexpr size_t WS_WPR = 117 * MiB;
constexpr size_t WS_WO = 121 * MiB;
constexpr size_t WS_W3 = 129 * MiB;
constexpr size_t WS_W4 = 173 * MiB;
constexpr size_t WS_XN = 195 * MiB;
constexpr size_t WS_KVF = WS_XN, WS_KVB = WS_XN + 66 * MiB;
constexpr size_t WS_R = 327 * MiB;
constexpr size_t WS_QA = WS_R, WS_KA = WS_R + 66 * MiB, WS_VA = WS_KA + 33 * MiB / 2, WS_QR = WS_R + 99 * MiB, WS_KR = WS_R + 165 * MiB,
                 WS_VR = WS_R + 231 * MiB, WS_GR = WS_R + 297 * MiB, WS_GA = WS_R + 363 * MiB, WS_GB = WS_R + 495 * MiB, WS_END = WS_R + 627 * MiB;
constexpr size_t WS_PART = WS_R + 400 * MiB;
constexpr int LDS_BYTES = 147456;

#define DI __device__ __forceinline__
DI unsigned f2bf(float f) { unsigned u = __builtin_bit_cast(unsigned, f); return (u + 0x7fffu + ((u >> 16) & 1u)) >> 16; }
DI unsigned pk2(float lo, float hi) { f32x2_t v = {lo, hi}; bf16x2_t b = __builtin_convertvector(v, bf16x2_t); return __builtin_bit_cast(unsigned, b); }
DI float bflo(unsigned w) { return __builtin_bit_cast(float, w << 16); }
DI float bfhi(unsigned w) { return __builtin_bit_cast(float, w & 0xffff0000u); }
DI float wave_sum(float v) {
#pragma unroll
    for (int o = 1; o < 64; o <<= 1) v += __shfl_xor(v, o);
    return v;
}
DI float sigmoidf_(float x) { return __builtin_amdgcn_rcpf(1.f + __expf(-x)); }
DI float siluf_(float x) { return x * sigmoidf_(x); }
#define LDS_WAIT() asm volatile("s_waitcnt lgkmcnt(0)" ::: "memory")

namespace pg8 {
#define PG8_LAS __attribute__((address_space(3)))
constexpr int BM = 256, BK = 64, HALF = 128, HTB = HALF * BK * 2, STAGE_BYTES = 8 * HTB, NXCD = 8, WGM = 8;
__host__ __device__ __forceinline__ int lds_byte(int r, int c) { const int st = (r >> 4) * 2 + (c >> 5), rr = r & 15, cc = c & 31, ob = rr * 64 + cc * 2; return st * 1024 + (ob ^ (((ob >> 9) & 1) << 5)); }
__host__ __device__ __forceinline__ void stage_rc(int b, int& R, int& C) { const int st = b / 1024, sb = b % 1024, swz = sb ^ (((sb >> 9) & 1) << 5); R = (st >> 1) * 16 + swz / 64; C = (st & 1) * 32 + (swz % 64) / 2; }
__host__ __device__ __forceinline__ int perm32(int rho) { const int n = rho >> 4, i = rho & 15; return 8 * (i >> 2) + 4 * n + (i & 3); }
struct Unit { int pm, pn, kt0, nt; };
struct Gemm { const bf16_t* A; const bf16_t* Bt; int M, N, K; };
struct StaticOrder {
    int nM, nN, nwg, G, c, ntk;
    __host__ __device__ void init(int M, int N, int K, int G_, int c_) { nM = M / BM; nN = N / BM; nwg = nM * nN; G = G_; c = c_; ntk = K / BK; }
    __host__ __device__ bool next(int i, Unit& u) const {
        const long L = (long)i * G + c; if (L >= nwg) return false;
        int wgid = (int)L; { const int q = nwg / NXCD, r = nwg % NXCD, xcd = wgid % NXCD, off = wgid / NXCD; wgid = (xcd < r ? xcd * (q + 1) : r * (q + 1) + (xcd - r) * q) + off; }
        const int nig = WGM * nN, gid = wgid / nig, fm = gid * WGM, gsz = (nM - fm) < WGM ? (nM - fm) : WGM;
        u.pm = fm + ((wgid % nig) % gsz); u.pn = (wgid % nig) / gsz; u.kt0 = 0; u.nt = ntk; return true;
    }
};
struct OrderDown1 {
    StaticOrder lat; int G, c;
    __host__ __device__ void init(int G_, int c_) { lat.init(TX, DM, DFF, G_, c_); G = G_; c = c_; }
    __host__ __device__ bool next(int i, Unit& u) const {
        const long L = (long)i * G + c; if (L < lat.nwg) return lat.next(i, u);
        const int j = (int)(L - lat.nwg); if (j >= 128) return false;
        u.kt0 = (j & 3) * 22; u.nt = 22; u.pn = (j >> 2) & 7; u.pm = TX / BM + (j >> 5); return true;
    }
};
template <class Epi, class Sched>
__device__ __forceinline__ void gemm_phase(PG8_LAS unsigned char* lds, const Gemm g, const Sched& S, const Epi& E) {
    int tid = threadIdx.x; asm volatile("" : "+v"(tid));
    const int wid = __builtin_amdgcn_readfirstlane(tid >> 6), lane = tid & 63, wr = wid >> 2, wc = wid & 3, fr = lane & 15, fq = lane >> 4;
    const int K = g.K;
    unsigned voffA[2], voffB[2];
#pragma unroll
    for (int i = 0; i < 2; ++i) { int R, C; stage_rc(tid * 16 + i * 8192, R, C); const int Rb = Epi::PERM ? ((R & ~31) + perm32(R & 31)) : R;
        voffA[i] = (unsigned)(R * K + C) * 2u; voffB[i] = (unsigned)(Rb * K + C) * 2u; }
    const size_t kstep = (size_t)(BK * 2);
    const size_t hstep = (size_t)HALF * K * 2;
    const size_t tstep = 2 * hstep;
    const unsigned ldsw = (unsigned)wid * 1024u;
    const int aoff = lds_byte(wr * 64 + fr, fq * 8), boff = lds_byte(wc * 32 + fr, fq * 8);
#define PG8_SA(b, h) (((b) * 2 + (h)) * HTB)
#define PG8_SB(b, h) ((4 + (b) * 2 + (h)) * HTB)
#define PG8_STAGE(bufoff, gbase, voff) do { _Pragma("unroll") for (int _i = 0; _i < 2; ++_i) \
        __builtin_amdgcn_global_load_lds((const unsigned*)((const char*)(gbase) + (voff)[_i]), (PG8_LAS unsigned*)(lds + (bufoff) + ldsw + _i * 8192), 16, 0, 0); } while (0)
#define PG8_LDA(dst, b, h) do { _Pragma("unroll") for (int m = 0; m < 4; ++m) _Pragma("unroll") for (int k = 0; k < 2; ++k) dst[m][k] = *(const PG8_LAS bf16x8*)(lds + PG8_SA(b, h) + aoff + m * 2048 + k * 1024); } while (0)
#define PG8_LDB(dst, b, h) do { _Pragma("unroll") for (int n = 0; n < 2; ++n) _Pragma("unroll") for (int k = 0; k < 2; ++k) dst[n][k] = *(const PG8_LAS bf16x8*)(lds + PG8_SB(b, h) + boff + n * 2048 + k * 1024); } while (0)
#define PG8_MMA(ai, bj, At, Bt) do { __builtin_amdgcn_s_setprio(1); _Pragma("unroll") for (int m = 0; m < 4; ++m) _Pragma("unroll") for (int n = 0; n < 2; ++n) _Pragma("unroll") for (int k = 0; k < 2; ++k) \
        acc[ai][bj][m][n] = __builtin_amdgcn_mfma_f32_16x16x32_bf16(Bt[n][k], At[m][k], acc[ai][bj][m][n], 0, 0, 0); __builtin_amdgcn_s_setprio(0); } while (0)
#define PG8_WAIT_V(n) asm volatile("s_waitcnt vmcnt(" #n ")" ::: "memory")
#define PG8_WAIT_L(n) asm volatile("s_waitcnt lgkmcnt(" #n ")" ::: "memory")
#define PG8_BAR __builtin_amdgcn_s_barrier()
#define PG8_SCHED __builtin_amdgcn_sched_barrier(0)
    Unit cur, nxt; int ui = 0;
    if (!S.next(0, cur)) return;
    f32x4 acc[2][2][4][2];
#pragma unroll
    for (int a = 0; a < 2; ++a)
#pragma unroll
        for (int b = 0; b < 2; ++b)
#pragma unroll
            for (int m = 0; m < 4; ++m)
#pragma unroll
                for (int n = 0; n < 2; ++n) acc[a][b][m][n] = (f32x4){0.f, 0.f, 0.f, 0.f};
    bf16x8 At[4][2], B0[2][2], B1[2][2];
    const char* cA = (const char*)g.A + (size_t)cur.pm * tstep + (size_t)cur.kt0 * kstep; const char* cB = (const char*)g.Bt + (size_t)cur.pn * tstep + (size_t)cur.kt0 * kstep;
    {
        PG8_STAGE(PG8_SB(0, 0), cB, voffB); PG8_STAGE(PG8_SB(0, 1), cB + hstep, voffB); PG8_STAGE(PG8_SA(0, 0), cA, voffA); PG8_STAGE(PG8_SA(0, 1), cA + hstep, voffA);
        if (wr == 1) PG8_BAR;
        PG8_WAIT_V(2); PG8_BAR;
        PG8_STAGE(PG8_SB(1, 0), cB + kstep, voffB); PG8_STAGE(PG8_SA(1, 0), cA + kstep, voffA); PG8_STAGE(PG8_SB(1, 1), cB + hstep + kstep, voffB);
        PG8_WAIT_V(6); PG8_BAR;
    }
    for (;;) {
        const bool has_next = S.next(ui + 1, nxt);
        const char* nA = has_next ? (const char*)g.A + (size_t)nxt.pm * tstep + (size_t)nxt.kt0 * kstep : cA; const char* nB = has_next ? (const char*)g.Bt + (size_t)nxt.pn * tstep + (size_t)nxt.kt0 * kstep : cB;
        const int nt = cur.nt;
        for (int t = 0; t < nt; t += 2) {
            const bool last = (t == nt - 2);
            const char* a1 = cA + (size_t)(t + 1) * kstep;
            const char* a2 = last ? nA : cA + (size_t)(t + 2) * kstep; const char* b2 = last ? nB : cB + (size_t)(t + 2) * kstep;
            const char* a3 = a2 + kstep; const char* b3 = b2 + kstep;
            PG8_LDB(B0, 0, 0); PG8_LDB(B1, 0, 1); PG8_SCHED; PG8_LDA(At, 0, 0); PG8_STAGE(PG8_SA(1, 1), a1 + hstep, voffA);
            PG8_WAIT_V(8); PG8_WAIT_L(0); PG8_BAR; PG8_MMA(0, 0, At, B0); PG8_MMA(0, 1, At, B1); PG8_BAR; PG8_SCHED;
            PG8_LDA(At, 0, 1); PG8_STAGE(PG8_SB(0, 0), b2, voffB); PG8_STAGE(PG8_SB(0, 1), b2 + hstep, voffB); PG8_STAGE(PG8_SA(0, 0), a2, voffA);
            PG8_WAIT_V(8); PG8_WAIT_L(0); PG8_BAR; PG8_MMA(1, 0, At, B0); PG8_MMA(1, 1, At, B1); PG8_BAR; PG8_SCHED;
            PG8_LDB(B0, 1, 0); PG8_LDB(B1, 1, 1); PG8_SCHED; PG8_LDA(At, 1, 0); PG8_STAGE(PG8_SA(0, 1), a2 + hstep, voffA);
            PG8_WAIT_V(8); PG8_WAIT_L(0); PG8_BAR; PG8_MMA(0, 0, At, B0); PG8_MMA(0, 1, At, B1); PG8_BAR; PG8_SCHED;
            PG8_LDA(At, 1, 1); PG8_STAGE(PG8_SB(1, 0), b3, voffB); PG8_STAGE(PG8_SB(1, 1), b3 + hstep, voffB); PG8_STAGE(PG8_SA(1, 0), a3, voffA);
            PG8_WAIT_V(8); PG8_WAIT_L(0); PG8_BAR; PG8_MMA(1, 0, At, B0); PG8_MMA(1, 1, At, B1); PG8_BAR; PG8_SCHED;
        }
        if (wr == 0) PG8_BAR;
        E(acc, cur, wr, wc, fr, fq);
        if (!has_next) break;
#pragma unroll
        for (int a = 0; a < 2; ++a)
#pragma unroll
            for (int b = 0; b < 2; ++b)
#pragma unroll
                for (int m = 0; m < 4; ++m)
#pragma unroll
                    for (int n = 0; n < 2; ++n) acc[a][b][m][n] = (f32x4){0.f, 0.f, 0.f, 0.f};
        cur = nxt; cA = nA; cB = nB; ++ui;
        if (wr == 1) PG8_BAR;
    }
    PG8_WAIT_V(0);
    PG8_BAR;
#undef PG8_SA
#undef PG8_SB
#undef PG8_STAGE
#undef PG8_LDA
#undef PG8_LDB
#undef PG8_MMA
#undef PG8_WAIT_V
#undef PG8_WAIT_L
#undef PG8_BAR
#undef PG8_SCHED
}

struct EpiSwiglu {
    static constexpr bool PERM = true;
    bf16_t* O;
    __device__ __forceinline__ void operator()(const f32x4 (&acc)[2][2][4][2], const Unit& u, int wr, int wc, int fr, int fq) const {
        const int row0 = u.pm * BM + wr * 64 + fr; const int col0 = u.pn * HALF + wc * 32 + 8 * fq;
#pragma unroll
        for (int ai = 0; ai < 2; ++ai)
#pragma unroll
            for (int m = 0; m < 4; ++m) {
                bf16_t* rowp = O + (size_t)(row0 + ai * HALF + m * 16) * DFF + col0;
                const f32x4 a0 = acc[ai][0][m][0], a1 = acc[ai][0][m][1], b0 = acc[ai][1][m][0], b1 = acc[ai][1][m][1];
                u32x4 w;
                w.x = pk2(siluf_(a0[0]) * b0[0], siluf_(a0[1]) * b0[1]); w.y = pk2(siluf_(a0[2]) * b0[2], siluf_(a0[3]) * b0[3]);
                w.z = pk2(siluf_(a1[0]) * b1[0], siluf_(a1[1]) * b1[1]); w.w = pk2(siluf_(a1[2]) * b1[2], siluf_(a1[3]) * b1[3]);
                *(u32x4*)rowp = w;
            }
    }
};
struct EpiResid {
    static constexpr bool PERM = false;
    const float* basex; const float* basec; float* outx; float* outc; const float* gate; float scale;
    __device__ __forceinline__ void operator()(const f32x4 (&acc)[2][2][4][2], const Unit& u, int wr, int wc, int fr, int fq) const {
        const bool isx = u.pm < TX / BM;
        const int col0 = u.pn * BM + wc * 32 + 4 * fq;
        if (!isx) {
            float* po = outc + ((size_t)(u.kt0 / 22) * TC + (size_t)(u.pm - TX / BM) * BM) * DM;
#pragma unroll
            for (int ai = 0; ai < 2; ++ai)
#pragma unroll
                for (int m = 0; m < 4; ++m) { const size_t off = (size_t)(wr * 64 + ai * HALF + m * 16 + fr) * DM + col0;
#pragma unroll
                    for (int bj = 0; bj < 2; ++bj)
#pragma unroll
                        for (int n = 0; n < 2; ++n) *(f32x4*)(po + off + bj * HALF + n * 16) = acc[ai][bj][m][n]; }
            return;
        }
        const int bidx = u.pm >> 5;
        const float* base = basex + (size_t)u.pm * BM * DM;
        float* out = outx + (size_t)u.pm * BM * DM;
        f32x4 gv[2][2];
#pragma unroll
        for (int bj = 0; bj < 2; ++bj)
#pragma unroll
            for (int n = 0; n < 2; ++n) gv[bj][n] = *(const f32x4*)(gate + (size_t)bidx * NMODW + col0 + bj * HALF + n * 16) * scale;
#pragma unroll
        for (int ai = 0; ai < 2; ++ai)
#pragma unroll
            for (int m = 0; m < 4; ++m) { const size_t off = (size_t)(wr * 64 + ai * HALF + m * 16 + fr) * DM + col0;
#pragma unroll
                for (int bj = 0; bj < 2; ++bj)
#pragma unroll
                    for (int n = 0; n < 2; ++n) { const f32x4 bs = *(const f32x4*)(base + off + bj * HALF + n * 16);
                        *(f32x4*)(out + off + bj * HALF + n * 16) = bs + gv[bj][n] * acc[ai][bj][m][n]; } }
    }
};
struct EpiProj {
    static constexpr bool PERM = true;
    unsigned char* ws;
    __device__ __forceinline__ void operator()(const f32x4 (&acc)[2][2][4][2], const Unit& u, int wr, int wc, int fr, int fq) const {
        const int pn = u.pn; size_t boff; int ldc, ct; float sc = 1.f;
        if (pn < 4) { boff = WS_QA; ldc = 1024; ct = pn; }
        else if (pn < 5) { boff = WS_KA; ldc = 256; ct = 0; }
        else if (pn < 6) { boff = WS_VA; ldc = 256; ct = 0; }
        else if (pn < 10) { boff = WS_QR; ldc = 1024; ct = pn - 6; }
        else if (pn < 14) { boff = WS_KR; ldc = 1024; ct = pn - 10; sc = 0.08838834764831845f; }
        else if (pn < 18) { boff = WS_VR; ldc = 1024; ct = pn - 14; }
        else if (pn < 22) { boff = WS_GR; ldc = 1024; ct = pn - 18; }
        else if (pn < 30) { boff = WS_GA; ldc = 2048; ct = pn - 22; }
        else { boff = WS_GB; ldc = 2048; ct = pn - 30; }
        bf16_t* O = (bf16_t*)(ws + boff);
        const int row0 = u.pm * BM + wr * 64 + fr; const int col0 = ct * BM + wc * 32 + 8 * fq;
#pragma unroll
        for (int ai = 0; ai < 2; ++ai)
#pragma unroll
            for (int m = 0; m < 4; ++m) { bf16_t* rowp = O + (size_t)(row0 + ai * HALF + m * 16) * ldc + col0;
#pragma unroll
                for (int bj = 0; bj < 2; ++bj) { const f32x4 v0 = acc[ai][bj][m][0] * sc, v1 = acc[ai][bj][m][1] * sc;
                    u32x4 w; w.x = pk2(v0[0], v0[1]); w.y = pk2(v0[2], v0[3]); w.z = pk2(v1[0], v1[1]); w.w = pk2(v1[2], v1[3]);
                    *(u32x4*)(rowp + bj * HALF) = w; } }
    }
};
template <int MODE> struct EpiMerge {
    static constexpr bool PERM = true;
    bf16_t* GA; const bf16_t* GB;
    __device__ __forceinline__ void operator()(const f32x4 (&acc)[2][2][4][2], const Unit& u, int wr, int wc, int fr, int fq) const {
        const int row0 = u.pm * BM + wr * 64 + fr; const int col0 = u.pn * BM + wc * 32 + 8 * fq;
#pragma unroll
        for (int ai = 0; ai < 2; ++ai)
#pragma unroll
            for (int m = 0; m < 4; ++m) { const size_t off = (size_t)(row0 + ai * HALF + m * 16) * DM + col0;
#pragma unroll
                for (int bj = 0; bj < 2; ++bj) { const f32x4 v0 = acc[ai][bj][m][0], v1 = acc[ai][bj][m][1];
                    const u32x4 ga = *(const u32x4*)(GA + off + bj * HALF); u32x4 w;
                    if (MODE == 0) {
                        w.x = pk2(sigmoidf_(bflo(ga.x)) * v0[0], sigmoidf_(bfhi(ga.x)) * v0[1]); w.y = pk2(sigmoidf_(bflo(ga.y)) * v0[2], sigmoidf_(bfhi(ga.y)) * v0[3]);
                        w.z = pk2(sigmoidf_(bflo(ga.z)) * v1[0], sigmoidf_(bfhi(ga.z)) * v1[1]); w.w = pk2(sigmoidf_(bflo(ga.w)) * v1[2], sigmoidf_(bfhi(ga.w)) * v1[3]);
                    } else {
                        const u32x4 gb = *(const u32x4*)(GB + off + bj * HALF);
                        w.x = pk2(bflo(ga.x) + sigmoidf_(bflo(gb.x)) * v0[0], bfhi(ga.x) + sigmoidf_(bfhi(gb.x)) * v0[1]); w.y = pk2(bflo(ga.y) + sigmoidf_(bflo(gb.y)) * v0[2], bfhi(ga.y) + sigmoidf_(bfhi(gb.y)) * v0[3]);
                        w.z = pk2(bflo(ga.z) + sigmoidf_(bflo(gb.z)) * v1[0], bfhi(ga.z) + sigmoidf_(bfhi(gb.z)) * v1[1]); w.w = pk2(bflo(ga.w) + sigmoidf_(bflo(gb.w)) * v1[2], bfhi(ga.w) + sigmoidf_(bfhi(gb.w)) * v1[3]);
                    }
                    *(u32x4*)(GA + off + bj * HALF) = w; } }
    }
};
}

namespace att {
constexpr int D = 128, NW = 8, QBLK = 32, KVBLK = 64;
constexpr float SCALE = 0.088388347648318440f;
constexpr float THR = 8.f;
constexpr size_t SHM_V = KVBLK * D * 2, SHM_K = KVBLK * D * 2;
#define KSWZ(row, colB) ((row) * 256 + ((colB) ^ (((row) & 7) << 4)))
#define SBAR() __builtin_amdgcn_sched_barrier(0)
DI int crow(int r, int hi) { return (r & 3) + 8 * (r >> 2) + 4 * hi; }
DI unsigned cvtpk(float lo, float hi) { return pk2(lo, hi); }
DI void partialSM(f32x16& p0, f32x16& p1, float& m_reg, float& mn, float& alpha) {
    constexpr float C = SCALE * 1.4426950408889634f;
    float pmax = p0[0];
#pragma unroll
    for (int r = 1; r < 16; ++r) pmax = fmaxf(pmax, p0[r]);
#pragma unroll
    for (int r = 0; r < 16; ++r) pmax = fmaxf(pmax, p1[r]);
    { auto rr = __builtin_amdgcn_permlane32_swap(__float_as_uint(pmax), __float_as_uint(pmax), false, false);
      pmax = fmaxf(__uint_as_float(rr[0]), __uint_as_float(rr[1])); }
    if (__builtin_expect(__all(pmax - m_reg <= THR / SCALE), 1)) { mn = m_reg; alpha = 1.f; }
    else { mn = fmaxf(m_reg, pmax); alpha = __builtin_amdgcn_exp2f((m_reg - mn) * C); m_reg = mn; }
    float mnC = -mn * C;
#pragma unroll
    for (int r = 0; r < 16; ++r) p0[r] = fmaf(p0[r], C, mnC);
#pragma unroll
    for (int r = 0; r < 16; ++r) p1[r] = fmaf(p1[r], C, mnC);
#pragma unroll
    for (int r = 0; r < 16; ++r) p0[r] = __builtin_amdgcn_exp2f(p0[r]);
}
#define PK4(P, BASE, OUT) do { unsigned a0 = cvtpk(P[BASE + 0], P[BASE + 1]), a1 = cvtpk(P[BASE + 2], P[BASE + 3]);   \
    unsigned b0 = cvtpk(P[BASE + 4], P[BASE + 5]), b1 = cvtpk(P[BASE + 6], P[BASE + 7]);                              \
    auto r0 = __builtin_amdgcn_permlane32_swap(a0, b0, false, false); auto r1 = __builtin_amdgcn_permlane32_swap(a1, b1, false, false); \
    u32x4 w = {r0[0], r1[0], r0[1], r1[1]}; OUT = __builtin_bit_cast(bf16x8, w); } while (0)
DI void finishSM(f32x16& p0, f32x16& p1, float alpha, float& l_reg, bf16x8& pa0, bf16x8& pa1, bf16x8& pa2, bf16x8& pa3) {
#pragma unroll
    for (int r = 0; r < 16; ++r) p1[r] = __builtin_amdgcn_exp2f(p1[r]);
    float ps = 0;
#pragma unroll
    for (int r = 0; r < 16; ++r) ps += p0[r];
#pragma unroll
    for (int r = 0; r < 16; ++r) ps += p1[r];
    { auto rr = __builtin_amdgcn_permlane32_swap(__float_as_uint(ps), __float_as_uint(ps), false, false);
      ps = __uint_as_float(rr[0]) + __uint_as_float(rr[1]); }
    l_reg = l_reg * alpha + ps;
    PK4(p0, 0, pa0); PK4(p0, 8, pa1); PK4(p1, 0, pa2); PK4(p1, 8, pa3);
}
DI void packP(const f32x16& p0, const f32x16& p1, bf16x8& pa0, bf16x8& pa1, bf16x8& pa2, bf16x8& pa3) {
    PK4(p0, 0, pa0); PK4(p0, 8, pa1); PK4(p1, 0, pa2); PK4(p1, 8, pa3);
}
DI void qkt(f32x16& p0, f32x16& p1, const char* Ks, const bf16x8* qr, int r32, int hi) {
    p0 = f32x16{}; p1 = f32x16{};
#pragma unroll
    for (int d0 = 0; d0 < 8; ++d0) { int cb = (d0 * 16 + hi * 8) * 2;
        bf16x8 b0 = *reinterpret_cast<const bf16x8*>(Ks + KSWZ(r32, cb));
        bf16x8 b1 = *reinterpret_cast<const bf16x8*>(Ks + KSWZ(32 + r32, cb));
        p0 = __builtin_amdgcn_mfma_f32_32x32x16_bf16(b0, qr[d0], p0, 0, 0, 0);
        p1 = __builtin_amdgcn_mfma_f32_32x32x16_bf16(b1, qr[d0], p1, 0, 0, 0); }
}
constexpr float THRL = THR * 1.4426950408889634f;
DI void qkt_m(f32x16& p0, f32x16& p1, const char* Ks, const bf16x8* qr, const f32x16& negm, int r32, int hi) {
#pragma unroll
    for (int d0 = 0; d0 < 8; ++d0) { int cb = (d0 * 16 + hi * 8) * 2;
        bf16x8 b0 = *reinterpret_cast<const bf16x8*>(Ks + KSWZ(r32, cb));
        bf16x8 b1 = *reinterpret_cast<const bf16x8*>(Ks + KSWZ(32 + r32, cb));
        if (d0 == 0) { p0 = __builtin_amdgcn_mfma_f32_32x32x16_bf16(b0, qr[0], negm, 0, 0, 0); p1 = __builtin_amdgcn_mfma_f32_32x32x16_bf16(b1, qr[0], negm, 0, 0, 0); }
        else { p0 = __builtin_amdgcn_mfma_f32_32x32x16_bf16(b0, qr[d0], p0, 0, 0, 0); p1 = __builtin_amdgcn_mfma_f32_32x32x16_bf16(b1, qr[d0], p1, 0, 0, 0); } }
}
DI void partialSM_m(f32x16& p0, f32x16& p1, float& m_reg, f32x16& negm, float& alpha) {
    float pmax = p0[0];
#pragma unroll
    for (int r = 1; r < 16; ++r) pmax = fmaxf(pmax, p0[r]);
#pragma unroll
    for (int r = 0; r < 16; ++r) pmax = fmaxf(pmax, p1[r]);
    { auto rr = __builtin_amdgcn_permlane32_swap(__float_as_uint(pmax), __float_as_uint(pmax), false, false);
      pmax = fmaxf(__uint_as_float(rr[0]), __uint_as_float(rr[1])); }
    alpha = 1.f;
    if (__builtin_expect(!__all(pmax <= THRL), 0)) {
        const float d = fmaxf(pmax, 0.f); m_reg += d; alpha = __builtin_amdgcn_exp2f(-d);
#pragma unroll
        for (int r = 0; r < 16; ++r) { p0[r] -= d; p1[r] -= d; }
#pragma unroll
        for (int r = 0; r < 16; ++r) negm[r] = -m_reg;
        asm volatile("" : "+v"(negm));
    }
#pragma unroll
    for (int r = 0; r < 16; ++r) p0[r] = __builtin_amdgcn_exp2f(p0[r]);
}
DI int v_st(int k, int c) { const int kk = (k & ~0xC) | ((k & 4) << 1) | ((k & 8) >> 1); return ((kk >> 3) * 4 + (c >> 5)) * 512 + ((kk & 7) * 32 + (c & 31)) * 2; }
DI int v_rd_base(int lane) { return ((lane & 3) << 3) | (((lane >> 2) & 3) << 6) | (((lane >> 4) & 1) << 5) | (((lane >> 5) & 1) << 8); }
constexpr int v_rd_off(int d0, int ks, int half) { return d0 * 512 + ks * 4096 + half * 2048; }
template <int OFF> DI s16x4 tr_read(int vb) {
    s16x4 r; asm volatile("ds_read_b64_tr_b16 %0, %1 offset:%2" : "=&v"(r) : "v"(vb), "i"(OFF) : "memory"); return r;
}
#define PKLH(L, H) (bf16x8){L[0], L[1], L[2], L[3], H[0], H[1], H[2], H[3]}
template <int TOFF, int D0, int KS> DI bf16x8 frag(int vb) {
    const s16x4 l = tr_read<TOFF + v_rd_off(D0, KS, 0)>(vb), h = tr_read<TOFF + v_rd_off(D0, KS, 1)>(vb);
    asm volatile("s_waitcnt lgkmcnt(0)" ::: "memory");
    return PKLH(l, h);
}
template <int D0> DI void pv_one(f32x16& od, int vb, bf16x8 pa0, bf16x8 pa1, bf16x8 pa2, bf16x8 pa3) {
    const s16x4 l0 = tr_read<v_rd_off(D0, 0, 0)>(vb), h0 = tr_read<v_rd_off(D0, 0, 1)>(vb), l1 = tr_read<v_rd_off(D0, 1, 0)>(vb), h1 = tr_read<v_rd_off(D0, 1, 1)>(vb);
    const s16x4 l2 = tr_read<v_rd_off(D0, 2, 0)>(vb), h2 = tr_read<v_rd_off(D0, 2, 1)>(vb), l3 = tr_read<v_rd_off(D0, 3, 0)>(vb), h3 = tr_read<v_rd_off(D0, 3, 1)>(vb);
    asm volatile("s_waitcnt lgkmcnt(0)" ::: "memory"); SBAR();
    od = __builtin_amdgcn_mfma_f32_32x32x16_bf16(pa0, PKLH(l0, h0), od, 0, 0, 0);
    od = __builtin_amdgcn_mfma_f32_32x32x16_bf16(pa1, PKLH(l1, h1), od, 0, 0, 0);
    od = __builtin_amdgcn_mfma_f32_32x32x16_bf16(pa2, PKLH(l2, h2), od, 0, 0, 0);
    od = __builtin_amdgcn_mfma_f32_32x32x16_bf16(pa3, PKLH(l3, h3), od, 0, 0, 0);
}
DI void pv_d0(f32x16* o, int vb, bf16x8 pa0, bf16x8 pa1, bf16x8 pa2, bf16x8 pa3) {
    pv_one<0>(o[0], vb, pa0, pa1, pa2, pa3); pv_one<1>(o[1], vb, pa0, pa1, pa2, pa3); pv_one<2>(o[2], vb, pa0, pa1, pa2, pa3); pv_one<3>(o[3], vb, pa0, pa1, pa2, pa3);
}

constexpr int LDQ = 1024, LDK = 256, LDO = 1024;
DI void attn_unit(const bf16_t* Qb, const bf16_t* Kc, const bf16_t* Kx, const bf16_t* Vc, const bf16_t* Vx, bf16_t* Ob, char* lds) {
    int tid = threadIdx.x; asm volatile("" : "+v"(tid));
    const int wid = tid >> 6, lane = tid & 63, r32 = lane & 31, hi = lane >> 5;
    char* V_lds = lds; char* K_lds = lds + 2 * SHM_V;
    float* ws = (float*)(lds + 2 * SHM_V + 2 * SHM_K) + wid * 64; float* li_l = ws; float* al_l = ws + 32;
    float m_reg = 0.f, l_reg = 0; f32x16 negm = {}; asm volatile("" : "+v"(negm)); f32x16 o[4] = {}; bf16x8 qr[8];
    const bf16_t* Qw = Qb + (long)(wid * QBLK + r32) * LDQ + hi * 8;
#pragma unroll
    for (int d0 = 0; d0 < 8; ++d0) qr[d0] = *reinterpret_cast<const bf16x8*>(Qw + d0 * 16);
    const int sr = tid >> 4, sc = (tid & 15) * 8, vst0 = v_st(sr, sc), vst1 = v_st(32 + sr, sc);
    const int vb0 = (int)(uintptr_t)V_lds + v_rd_base(lane);
    struct { bf16x8 vs0, vs1, ks0, ks1; } sr_[1];
#define KVP(P, k0) (((k0) < CTX ? P##c + (long)(k0) * LDK : P##x + (long)((k0) - CTX) * LDK))
#define SLOAD(i, k0) do { const bf16_t* vp_ = KVP(V, k0); const bf16_t* kp_ = KVP(K, k0); \
    sr_[i].vs0 = *reinterpret_cast<const bf16x8*>(&vp_[(long)sr * LDK + sc]); sr_[i].vs1 = *reinterpret_cast<const bf16x8*>(&vp_[(long)(32 + sr) * LDK + sc]); \
    sr_[i].ks0 = *reinterpret_cast<const bf16x8*>(&kp_[(long)sr * LDK + sc]); sr_[i].ks1 = *reinterpret_cast<const bf16x8*>(&kp_[(long)(32 + sr) * LDK + sc]); } while (0)
#define SWRITE(b, i) do { *(bf16x8*)(V_lds + (b) * SHM_V + vst0) = sr_[i].vs0;          \
    *(bf16x8*)(V_lds + (b) * SHM_V + vst1) = sr_[i].vs1; int kc = sc * 2;               \
    *(bf16x8*)(K_lds + (b) * SHM_K + KSWZ(sr, kc)) = sr_[i].ks0;                       \
    *(bf16x8*)(K_lds + (b) * SHM_K + KSWZ(32 + sr, kc)) = sr_[i].ks1; } while (0)
#define SWAIT() asm volatile("s_waitcnt vmcnt(0)" ::: "memory")
#define RESC(a) do { if (__any((a) < 1.f)) { if (hi == 0) al_l[r32] = (a); asm volatile("s_waitcnt lgkmcnt(0)" ::: "memory"); \
    _Pragma("unroll") for (int d = 0; d < 4; ++d) _Pragma("unroll") for (int r = 0; r < 16; ++r) o[d][r] *= al_l[crow(r, hi)]; } } while (0)
    f32x16 pA0, pA1, pB0, pB1; float alA, alB; bf16x8 pa0, pa1, pa2, pa3; constexpr int NT = (CTX + SEQ) / KVBLK;
    constexpr int SE = 0, SO = 0;
    SLOAD(SE, 0); asm volatile("s_waitcnt vmcnt(0)" ::: "memory"); SWRITE(0, SE); __syncthreads();
    qkt_m(pA0, pA1, K_lds, qr, negm, r32, hi); partialSM_m(pA0, pA1, m_reg, negm, alA);
    SLOAD(SO, KVBLK);
    SWAIT(); SWRITE(1, SO); __syncthreads();
    for (int j = 1; j + 1 < NT; j += 2) {
        SBAR(); qkt_m(pB0, pB1, K_lds + SHM_K, qr, negm, r32, hi);
        finishSM(pA0, pA1, alA, l_reg, pa0, pa1, pa2, pa3); SBAR();
        SLOAD(SO, (j + 1) * KVBLK); SBAR();
        pv_d0(o, vb0, pa0, pa1, pa2, pa3); partialSM_m(pB0, pB1, m_reg, negm, alB);
        __syncthreads(); SWAIT(); SWRITE(0, SE);
        RESC(alB); __syncthreads();
        SBAR(); qkt_m(pA0, pA1, K_lds, qr, negm, r32, hi);
        finishSM(pB0, pB1, alB, l_reg, pa0, pa1, pa2, pa3); SBAR();
        SLOAD(SE, (j + 2) * KVBLK); SBAR();
        pv_d0(o, vb0 + (int)SHM_V, pa0, pa1, pa2, pa3); partialSM_m(pA0, pA1, m_reg, negm, alA);
        __syncthreads(); SWAIT(); SWRITE(1, SO);
        RESC(alA); __syncthreads();
    }
    SBAR(); qkt_m(pB0, pB1, K_lds + SHM_K, qr, negm, r32, hi);
    finishSM(pA0, pA1, alA, l_reg, pa0, pa1, pa2, pa3); SBAR();
    pv_d0(o, vb0, pa0, pa1, pa2, pa3); partialSM_m(pB0, pB1, m_reg, negm, alB);
    __syncthreads(); RESC(alB);
    finishSM(pB0, pB1, alB, l_reg, pa0, pa1, pa2, pa3); SBAR();
    pv_d0(o, vb0 + (int)SHM_V, pa0, pa1, pa2, pa3);
    if (hi == 0) li_l[r32] = l_reg; asm volatile("s_waitcnt lgkmcnt(0)" ::: "memory");
    float rli[16];
#pragma unroll
    for (int r = 0; r < 16; ++r) rli[r] = __builtin_amdgcn_rcpf(li_l[crow(r, hi)]);
    bf16_t* Ow = Ob + (long)(wid * QBLK) * LDO;
#pragma unroll
    for (int r = 0; r < 16; ++r) { int orow = crow(r, hi);
#pragma unroll
        for (int d0 = 0; d0 < 4; ++d0) Ow[(long)orow * LDO + d0 * 32 + r32] = (bf16_t)f2bf(o[d0][r] * rli[r]); }
    __syncthreads();
#undef KVP
#undef SLOAD
#undef SWRITE
#undef SWAIT
#undef RESC
}

DI void stage_v128(char* dst, const bf16_t* src, int ld, int tid) {
    const int sr = tid >> 4, sc = (tid & 15) * 8;
    bf16x8 v[4];
#pragma unroll
    for (int i = 0; i < 4; ++i) v[i] = *reinterpret_cast<const bf16x8*>(src + (long)(32 * i + sr) * ld + sc);
#pragma unroll
    for (int i = 0; i < 4; ++i) *(bf16x8*)(dst + (i >> 1) * 16384 + v_st((i & 1) * 32 + sr, sc)) = v[i];
}
DI void stage_k128(char* dst, const bf16_t* src, int ld, int tid) {
    const int sr = tid >> 4, sc = (tid & 15) * 8;
    bf16x8 v[4];
#pragma unroll
    for (int i = 0; i < 4; ++i) v[i] = *reinterpret_cast<const bf16x8*>(src + (long)(32 * i + sr) * ld + sc);
#pragma unroll
    for (int i = 0; i < 4; ++i) *(bf16x8*)(dst + (i >> 1) * 16384 + KSWZ((i & 1) * 32 + sr, sc * 2)) = v[i];
}
DI bf16x8 scale8(bf16x8 a, const float* w) {
    const u32x4 u = __builtin_bit_cast(u32x4, a); u32x4 o;
    o.x = pk2(bflo(u.x) * w[0], bfhi(u.x) * w[1]); o.y = pk2(bflo(u.y) * w[2], bfhi(u.y) * w[3]);
    o.z = pk2(bflo(u.z) * w[4], bfhi(u.z) * w[5]); o.w = pk2(bflo(u.w) * w[6], bfhi(u.w) * w[7]);
    return __builtin_bit_cast(bf16x8, o);
}
DI bf16x8 scale1(bf16x8 a, float s) {
    const u32x4 u = __builtin_bit_cast(u32x4, a); u32x4 o;
    o.x = pk2(bflo(u.x) * s, bfhi(u.x) * s); o.y = pk2(bflo(u.y) * s, bfhi(u.y) * s);
    o.z = pk2(bflo(u.z) * s, bfhi(u.z) * s); o.w = pk2(bflo(u.w) * s, bfhi(u.w) * s);
    return __builtin_bit_cast(bf16x8, o);
}
template <int KS> DI void kv_step(f32x16 (&cf)[2], f32x16 (&cb)[2], int vbK, int vbV, const float* wf, const float* wb, int hi) {
    constexpr int TOFF = (KS >> 2) * 16384, K4 = KS & 3;
    const bf16x8 a = frag<TOFF, 0, K4>(vbK);
    const bf16x8 b0 = frag<32768 + TOFF, 0, K4>(vbV), b1 = frag<32768 + TOFF, 1, K4>(vbV);
    float w8[8];
#pragma unroll
    for (int e = 0; e < 8; ++e) w8[e] = wf[16 * KS + 8 * hi + e];
    const bf16x8 af = scale8(a, w8);
#pragma unroll
    for (int e = 0; e < 8; ++e) w8[e] = wb[16 * KS + 8 * hi + e];
    const bf16x8 ab = scale8(a, w8);
    cf[0] = __builtin_amdgcn_mfma_f32_32x32x16_bf16(af, b0, cf[0], 0, 0, 0); cf[1] = __builtin_amdgcn_mfma_f32_32x32x16_bf16(af, b1, cf[1], 0, 0, 0);
    cb[0] = __builtin_amdgcn_mfma_f32_32x32x16_bf16(ab, b0, cb[0], 0, 0, 0); cb[1] = __builtin_amdgcn_mfma_f32_32x32x16_bf16(ab, b1, cb[1], 0, 0, 0);
}
DI void kv_unit(char* lds, const bf16_t* Ksrc, const bf16_t* Vsrc, bf16_t* KVf, bf16_t* KVb, float lgf2, float lgb2) {
    int tid = threadIdx.x; asm volatile("" : "+v"(tid));
    const int wid = tid >> 6, lane = tid & 63, r32 = lane & 31, hi = lane >> 5;
    float* wf = (float*)(lds + 65536); float* wb = wf + 128;
    stage_v128(lds, Ksrc, 1024, tid); stage_v128(lds + 32768, Vsrc, 1024, tid);
    if (tid < 128) wf[tid] = __builtin_amdgcn_exp2f(lgf2 * (float)(127 - tid)); else if (tid < 256) wb[tid - 128] = __builtin_amdgcn_exp2f(lgb2 * (float)(tid - 128));
    __syncthreads();
    const int db = wid & 3, eh = wid >> 2;
    const int vbK = (int)(uintptr_t)lds + v_rd_base(lane) + db * 512, vbV = (int)(uintptr_t)lds + v_rd_base(lane) + eh * 1024;
    f32x16 cf[2] = {}, cb[2] = {};
    kv_step<0>(cf, cb, vbK, vbV, wf, wb, hi); kv_step<1>(cf, cb, vbK, vbV, wf, wb, hi); kv_step<2>(cf, cb, vbK, vbV, wf, wb, hi); kv_step<3>(cf, cb, vbK, vbV, wf, wb, hi);
    kv_step<4>(cf, cb, vbK, vbV, wf, wb, hi); kv_step<5>(cf, cb, vbK, vbV, wf, wb, hi); kv_step<6>(cf, cb, vbK, vbV, wf, wb, hi); kv_step<7>(cf, cb, vbK, vbV, wf, wb, hi);
#pragma unroll
    for (int eb = 0; eb < 2; ++eb)
#pragma unroll
        for (int r = 0; r < 16; ++r) { const int d = 32 * db + crow(r, hi), e = 64 * eh + 32 * eb + r32;
            KVf[d * 128 + e] = (bf16_t)f2bf(cf[eb][r]); KVb[d * 128 + e] = (bf16_t)f2bf(cb[eb][r]); }
    __syncthreads();
}
template <int TOFF, int KS> DI void cross_step(f32x16* o, int vb, bf16x8 a) {
    const bf16x8 b0 = frag<TOFF, 0, KS>(vb), b1 = frag<TOFF, 1, KS>(vb), b2 = frag<TOFF, 2, KS>(vb), b3 = frag<TOFF, 3, KS>(vb);
    o[0] = __builtin_amdgcn_mfma_f32_32x32x16_bf16(a, b0, o[0], 0, 0, 0); o[1] = __builtin_amdgcn_mfma_f32_32x32x16_bf16(a, b1, o[1], 0, 0, 0);
    o[2] = __builtin_amdgcn_mfma_f32_32x32x16_bf16(a, b2, o[2], 0, 0, 0); o[3] = __builtin_amdgcn_mfma_f32_32x32x16_bf16(a, b3, o[3], 0, 0, 0);
}
DI void cross8(f32x16* o, int vb, const bf16x8* qr, float s) {
    cross_step<0, 0>(o, vb, scale1(qr[0], s)); cross_step<0, 1>(o, vb, scale1(qr[1], s)); cross_step<0, 2>(o, vb, scale1(qr[2], s)); cross_step<0, 3>(o, vb, scale1(qr[3], s));
    cross_step<16384, 0>(o, vb, scale1(qr[4], s)); cross_step<16384, 1>(o, vb, scale1(qr[5], s)); cross_step<16384, 2>(o, vb, scale1(qr[6], s)); cross_step<16384, 3>(o, vb, scale1(qr[7], s));
}
DI void ret_unit(char* lds, const bf16_t* Qb, const bf16_t* Kb, const bf16_t* Vb, const bf16_t* Gb, bf16_t* Yb,
                 const bf16_t* Sf, const bf16_t* Sb, float lgf2, float lgb2) {
    int tid = threadIdx.x; asm volatile("" : "+v"(tid));
    const int wid = tid >> 6, lane = tid & 63, r32 = lane & 31, hi = lane >> 5;
    const int cw = wid >> 2, iw = 32 * (wid & 3) + r32;
    bf16x8 qr[8];
    const bf16_t* Qw = Qb + (long)(wid * QBLK + r32) * 1024 + hi * 8;
#pragma unroll
    for (int d0 = 0; d0 < 8; ++d0) qr[d0] = *reinterpret_cast<const bf16x8*>(Qw + d0 * 16);
    stage_k128(lds, Kb, 1024, tid); stage_k128(lds + 32768, Kb + 128 * 1024, 1024, tid);
    stage_v128(lds + 65536, Vb, 1024, tid); stage_v128(lds + 98304, Vb + 128 * 1024, 1024, tid);
    __syncthreads();
    f32x16 o[4] = {};
    const int vbase = (int)(uintptr_t)lds + v_rd_base(lane);
#pragma unroll
    for (int kt = 0; kt < 2; ++kt) {
        f32x16 p0, p1; bf16x8 pa0, pa1, pa2, pa3;
        qkt(p0, p1, lds + cw * 32768 + kt * 16384, qr, r32, hi);
        int iwv = iw - 64 * kt - 4 * hi; asm volatile("" : "+v"(iwv));
#pragma unroll
        for (int r = 0; r < 16; ++r) {
            const int d0 = iwv - ((r & 3) + 8 * (r >> 2)), d1 = d0 - 32;
            const float f0 = (float)d0, f1 = (float)d1;
            float m0 = __builtin_amdgcn_exp2f(d0 > 0 ? lgf2 * f0 : -lgb2 * f0), m1 = __builtin_amdgcn_exp2f(d1 > 0 ? lgf2 * f1 : -lgb2 * f1);
            m0 = d0 == 0 ? 2.f : m0; m1 = d1 == 0 ? 2.f : m1;
            p0[r] *= m0; p1[r] *= m1;
        }
        packP(p0, p1, pa0, pa1, pa2, pa3); SBAR();
        pv_d0(o, vbase + 65536 + cw * 32768 + kt * 16384, pa0, pa1, pa2, pa3);
    }
    __syncthreads();
    stage_v128(lds, Sf, 128, tid); stage_v128(lds + 32768, Sf + 16384, 128, tid);
    stage_v128(lds + 65536, Sb, 128, tid); stage_v128(lds + 98304, Sb + 16384, 128, tid);
    __syncthreads();
    cross8(o, vbase + cw * 32768, qr, __builtin_amdgcn_exp2f(lgf2 * (float)(iw + 1)));
    cross8(o, vbase + 65536 + cw * 32768, qr, __builtin_amdgcn_exp2f(lgb2 * (float)(128 - iw)));
    __syncthreads();
    char* st = lds + wid * 8192;
#pragma unroll
    for (int r = 0; r < 16; ++r) {
        float s = o[0][r] * o[0][r] + o[1][r] * o[1][r] + o[2][r] * o[2][r] + o[3][r] * o[3][r];
        s += __shfl_xor(s, 1); s += __shfl_xor(s, 2); s += __shfl_xor(s, 4); s += __shfl_xor(s, 8); s += __shfl_xor(s, 16);
        const float rstd = rsqrtf(s * (1.f / 128.f) + NEPS);
        const int orow = crow(r, hi);
#pragma unroll
        for (int d0 = 0; d0 < 4; ++d0) *(bf16_t*)(st + orow * 256 + (d0 * 32 + r32) * 2) = (bf16_t)f2bf(o[d0][r] * rstd);
    }
    LDS_WAIT();
    const bf16_t* Gw = Gb + (long)(wid * QBLK) * 1024; bf16_t* Yw = Yb + (long)(wid * QBLK) * 1024;
#pragma unroll 2
    for (int i = 0; i < 8; ++i) {
        const int c = i * 64 + lane, row = c >> 4, col8 = (c & 15) * 8;
        const u32x4 y = *(const u32x4*)(st + row * 256 + col8 * 2); const u32x4 g = *(const u32x4*)(Gw + (long)row * 1024 + col8); u32x4 w;
        w.x = pk2(siluf_(bflo(g.x)) * bflo(y.x), siluf_(bfhi(g.x)) * bfhi(y.x)); w.y = pk2(siluf_(bflo(g.y)) * bflo(y.y), siluf_(bfhi(g.y)) * bfhi(y.y));
        w.z = pk2(siluf_(bflo(g.z)) * bflo(y.z), siluf_(bfhi(g.z)) * bfhi(y.z)); w.w = pk2(siluf_(bflo(g.w)) * bflo(y.w), siluf_(bfhi(g.w)) * bfhi(y.w));
        *(u32x4*)(Yw + (long)row * 1024 + col8) = w;
    }
    __syncthreads();
}
}

DI void transpose_item(const float* W, int N, bf16_t* WT, int K, int k0, int n0, int drow0, float* scr, int lane) {
#pragma unroll 8
    for (int i = 0; i < 32; ++i) { const int kk = 2 * i + (lane >> 5); scr[kk * 33 + (lane & 31)] = W[(size_t)(k0 + kk) * N + n0 + (lane & 31)]; }
    LDS_WAIT();
    const int c = lane & 7;
#pragma unroll
    for (int j = 0; j < 4; ++j) { const int n = (lane >> 3) + 8 * j; const float* s = scr + (8 * c) * 33 + n;
        u32x4 o; o.x = pk2(s[0 * 33], s[1 * 33]); o.y = pk2(s[2 * 33], s[3 * 33]); o.z = pk2(s[4 * 33], s[5 * 33]); o.w = pk2(s[6 * 33], s[7 * 33]);
        *(u32x4*)(WT + (size_t)(drow0 + n) * K + k0 + 8 * c) = o; }
    LDS_WAIT();
}
DI int swiglu_row(int n0) { return n0 < DFF ? 256 * (n0 >> 7) + (n0 & 127) : 256 * ((n0 - DFF) >> 7) + 128 + ((n0 - DFF) & 127); }

DI void norm_rows(const float* srcx, const float* srcc, const float* mod, int ish, int isc, bf16_t* dst, int nrows, int gw, int NGW, int lane) {
    for (int r = gw; r < nrows; r += NGW) {
        const float* src; int bidx;
        if (r < TX) { src = srcx + (size_t)r * DM; bidx = r >> 13; } else { src = srcc + (size_t)(r - TX) * DM; bidx = 4; }
        const float* sh = mod + (size_t)bidx * NMODW + ish * DM; const float* sc = mod + (size_t)bidx * NMODW + isc * DM;
        f32x4 v[8]; float ss = 0.f;
#pragma unroll
        for (int j = 0; j < 8; ++j) { v[j] = ((const f32x4*)src)[lane + 64 * j]; ss += v[j].x * v[j].x + v[j].y * v[j].y + v[j].z * v[j].z + v[j].w * v[j].w; }
        const float rstd = rsqrtf(wave_sum(ss) * (1.f / DM) + NEPS);
#pragma unroll
        for (int j = 0; j < 8; ++j) { const int col = 4 * lane + 256 * j; const f32x4 s4 = *(const f32x4*)(sc + col), h4 = *(const f32x4*)(sh + col);
            const f32x4 o = v[j] * rstd * (s4 + 1.f) + h4; u32x2 w; w.x = pk2(o.x, o.y); w.y = pk2(o.z, o.w);
            *(u32x2*)(dst + (size_t)r * DM + col) = w; }
    }
}


#define LASQ __attribute__((address_space(3)))
#define XB_TMO      128
#define XB_XCNT(j)  (256  + 64 * (j))
#define XB_XSUB(j)  (1280 + 64 * (j))
#define XB_XGEN(j)  (2304 + 64 * (j))
#define XB_TOP      3328
#define XB_TOPGEN   3392
#define XCD_BAR_WORDS 3456
#define XB_SPIN_CAP (1u << 18)
__device__ __forceinline__ unsigned xb_ld(unsigned* p)              { return __hip_atomic_load(p, __ATOMIC_RELAXED, __HIP_MEMORY_SCOPE_AGENT); }
__device__ __forceinline__ unsigned xb_add(unsigned* p, unsigned v) { return __hip_atomic_fetch_add(p, v, __ATOMIC_RELAXED, __HIP_MEMORY_SCOPE_AGENT); }
__device__ __forceinline__ unsigned xb_xcc_id() { return (unsigned)__builtin_amdgcn_s_getreg((3 << 11) | 20) & 0xFu; }
#define XB_SPIN(cond, bar) do { unsigned _sp = 0; while (cond) { __builtin_amdgcn_s_sleep(1); \
    if ((++_sp & 255u) == 0u) { if (xb_ld(&(bar)[XB_TMO])) break; if (_sp > XB_SPIN_CAP) { atomicAdd(&(bar)[XB_TMO], 1u); break; } } } } while (0)
struct XcdBarrier { unsigned* bar; unsigned x; volatile LASQ unsigned* st; };
__device__ __forceinline__ XcdBarrier xcd_barrier_post(unsigned* bar, volatile LASQ unsigned* st) {
    XcdBarrier b; b.bar = bar; b.x = xb_xcc_id(); b.st = st;
    if (threadIdx.x == 0) (void)xb_add(&bar[XB_XCNT(b.x)], 1u);
    return b;
}
__device__ __forceinline__ void xcd_barrier_complete(unsigned* bar, unsigned x, unsigned& nloc, unsigned& nx) {
    const unsigned G = gridDim.x * gridDim.y * gridDim.z;
    unsigned sum, cnt, mine, sp = 0u;
    for (;;) {
        sum = 0u; cnt = 0u; mine = 0u;
#pragma unroll
        for (unsigned j = 0; j < 16; ++j) { const unsigned c = xb_ld(&bar[XB_XCNT(j)]); sum += c; cnt += (c > 0u) ? 1u : 0u; mine = (j == x) ? c : mine; }
        if (sum == G) break;
        __builtin_amdgcn_s_sleep(1);
        if ((++sp & 255u) == 0u) { if (xb_ld(&bar[XB_TMO])) break; if (sp > XB_SPIN_CAP) { atomicAdd(&bar[XB_TMO], 1u); break; } }
    }
    nloc = mine > 0u ? mine : 1u; nx = cnt > 0u ? cnt : 1u;
}
__device__ __forceinline__ void xcd_barrier(const XcdBarrier& b) {
    asm volatile("s_waitcnt vmcnt(0)" ::: "memory");
    __syncthreads();
    if (threadIdx.x == 0) {
        unsigned* bar = b.bar;
        __builtin_amdgcn_s_waitcnt(0);
        unsigned nloc = b.st[0], nx = b.st[1];
        if (nloc == 0u) { xcd_barrier_complete(bar, b.x, nloc, nx); b.st[0] = nloc; b.st[1] = nx; }
        const unsigned old = xb_add(&bar[XB_XSUB(b.x)], 1u);
        const unsigned gen = old / nloc;
        if (old + 1u == (gen + 1u) * nloc) {
            __builtin_amdgcn_fence(__ATOMIC_RELEASE, "agent");
            asm volatile("s_waitcnt vmcnt(0)" ::: "memory");
            const unsigned og = xb_add(&bar[XB_TOP], 1u);
            const unsigned tg = og / nx;
            if (og + 1u == (tg + 1u) * nx) xb_add(&bar[XB_TOPGEN], 1u);
            else XB_SPIN(xb_ld(&bar[XB_TOPGEN]) == tg, bar);
            __builtin_amdgcn_fence(__ATOMIC_ACQUIRE, "agent");
            xb_add(&bar[XB_XGEN(b.x)], 1u);
            asm volatile("s_waitcnt vmcnt(0)" ::: "memory");
        } else {
            XB_SPIN(xb_ld(&bar[XB_XGEN(b.x)]) == gen, bar);
            __builtin_amdgcn_fence(__ATOMIC_ACQUIRE, "agent");
            asm volatile("s_waitcnt vmcnt(0)" ::: "memory");
        }
    }
    __syncthreads();
}

#ifndef PHMASK
#define PHMASK 0xFFFF
#endif
struct Args { const float* in[18]; float* out; unsigned char* ws; };

__global__ void __launch_bounds__(512, 2) mega_fwd(Args a) {
    extern __shared__ __attribute__((aligned(16))) unsigned char lds[];
    cg::grid_group grid = cg::this_grid();
    const int tid = threadIdx.x, lane = tid & 63, wave = __builtin_amdgcn_readfirstlane(tid >> 6);
    const int G = gridDim.x, bid = blockIdx.x;
    const int gw = bid * 8 + wave, NGW = G * 8;
    unsigned char* ws = a.ws;
    const float* x = a.in[0]; const float* cvec = a.in[1]; const float* ctx = a.in[2]; const float* cctx = a.in[3];
    const float* w_ada = a.in[4]; const float* b_ada = a.in[5];
    float* mod = (float*)(ws + WS_MOD);
    bf16_t* W1 = (bf16_t*)(ws + WS_W1); bf16_t* W2 = (bf16_t*)(ws + WS_W2); bf16_t* WIN = (bf16_t*)(ws + WS_WIN); bf16_t* WPA = (bf16_t*)(ws + WS_WPA);
    bf16_t* WPR = (bf16_t*)(ws + WS_WPR); bf16_t* WO = (bf16_t*)(ws + WS_WO); bf16_t* W3 = (bf16_t*)(ws + WS_W3); bf16_t* W4 = (bf16_t*)(ws + WS_W4);
    bf16_t* XN = (bf16_t*)(ws + WS_XN); bf16_t* HID = (bf16_t*)(ws + WS_R);
    PG8_LAS unsigned char* ldsl = (PG8_LAS unsigned char*)lds;

    unsigned* barw = (unsigned*)(ws + WS_MOD + 640 * 1024);
    volatile LASQ unsigned* bst = (volatile LASQ unsigned*)((LASQ unsigned char*)lds + LDS_BYTES - 64);
    if (bid == 0) for (int i = tid; i < XCD_BAR_WORDS; i += 512) barw[i] = 0u;
    if (tid < 2) bst[tid] = 0u;
    __syncthreads();
    if constexpr ((PHMASK >> 0) & 1) {
    if (bid < 72) {
        float* sc = (float*)lds; float* red = (float*)(lds + 40960);
        for (int i = tid; i < 5 * DM; i += 512) { const int c = i / DM, k = i % DM; const float v = c < 4 ? cvec[c * DM + k] : cctx[k]; sc[i] = v / (1.f + __expf(-v)); }
        __syncthreads();
        const int n0 = bid * 256 + lane * 4;
        float acc[5][4];
#pragma unroll
        for (int c = 0; c < 5; ++c)
#pragma unroll
            for (int j = 0; j < 4; ++j) acc[c][j] = 0.f;
#pragma unroll 8
        for (int k = wave * 256; k < wave * 256 + 256; ++k) { const f32x4 w = *(const f32x4*)(w_ada + (size_t)k * NMODW + n0);
#pragma unroll
            for (int c = 0; c < 5; ++c) { const float s = sc[c * DM + k]; acc[c][0] += s * w.x; acc[c][1] += s * w.y; acc[c][2] += s * w.z; acc[c][3] += s * w.w; } }
#pragma unroll
        for (int c = 0; c < 5; ++c)
#pragma unroll
            for (int j = 0; j < 4; ++j) red[(wave * 5 + c) * 256 + lane * 4 + j] = acc[c][j];
        __syncthreads();
        for (int i = tid; i < 5 * 256; i += 512) { const int c = i >> 8, n = i & 255; float s = 0.f;
#pragma unroll
            for (int w = 0; w < 8; ++w) s += red[(w * 5 + c) * 256 + n];
            mod[(size_t)c * NMODW + bid * 256 + n] = s + b_ada[bid * 256 + n]; }
        __syncthreads();
    }
    {
        float* scr = (float*)(lds + wave * 16384);
        constexpr int I1 = 32 * 352, I2 = 88 * 64, IIN = 32 * 304, IPA = 16 * 64, IO = 32 * 64;
        constexpr int NIT = 2 * I1 + 2 * I2 + IIN + 2 * IPA + IO;
        const int nslot = (G > 72) ? 576 + (G - 72) * 16 : NGW;
        const int slot0 = (G > 72 && bid >= 72) ? 576 + ((bid - 72) * 8 + wave) * 2 : gw, nown = (G > 72 && bid >= 72) ? 2 : 1;
        for (int so = 0; so < nown; ++so)
        for (int it = slot0 + so; it < NIT; it += nslot) {
            int r = it;
            if (r < I1) { const int kb = r / 352, nb = r % 352; transpose_item(a.in[6], 2 * DFF, W1, DM, 64 * kb, 32 * nb, swiglu_row(32 * nb), scr, lane); continue; } r -= I1;
            if (r < I2) { const int kb = r / 64, nb = r % 64; transpose_item(a.in[7], DM, W2, DFF, 64 * kb, 32 * nb, 32 * nb, scr, lane); continue; } r -= I2;
            if (r < IIN) { const int kb = r / 304, nb = r % 304; transpose_item(a.in[8], PW, WIN, DM, 64 * kb, 32 * nb, 32 * nb, scr, lane); continue; } r -= IIN;
            if (r < IPA) { const int kb = r / 64, nb = r % 64; transpose_item(a.in[12], DM, WPA, 1024, 64 * kb, 32 * nb, 32 * nb, scr, lane); continue; } r -= IPA;
            if (r < IPA) { const int kb = r / 64, nb = r % 64; transpose_item(a.in[13], DM, WPR, 1024, 64 * kb, 32 * nb, 32 * nb, scr, lane); continue; } r -= IPA;
            if (r < IO) { const int kb = r / 64, nb = r % 64; transpose_item(a.in[14], DM, WO, DM, 64 * kb, 32 * nb, 32 * nb, scr, lane); continue; } r -= IO;
            if (r < I1) { const int kb = r / 352, nb = r % 352; transpose_item(a.in[15], 2 * DFF, W3, DM, 64 * kb, 32 * nb, swiglu_row(32 * nb), scr, lane); continue; } r -= I1;
            { const int kb = r / 64, nb = r % 64; transpose_item(a.in[16], DM, W4, DFF, 64 * kb, 32 * nb, 32 * nb, scr, lane); }
        }
    }
    }
    grid.sync();
    XcdBarrier xb = xcd_barrier_post(barw, bst);

    if constexpr ((PHMASK >> 1) & 1) {
    norm_rows(x, ctx, mod, 0, 1, XN, TT, gw, NGW, lane);
    }
    xcd_barrier(xb);

    if constexpr ((PHMASK >> 2) & 1) {
    { pg8::Gemm g{XN, W1, TT, 2 * DFF, DM}; pg8::StaticOrder S; S.init(TT, 2 * DFF, DM, G, bid); pg8::EpiSwiglu E{HID};
      pg8::gemm_phase<pg8::EpiSwiglu, pg8::StaticOrder>(ldsl, g, S, E); }
    }
    xcd_barrier(xb);

    if constexpr ((PHMASK >> 3) & 1) {
    { pg8::Gemm g{HID, W2, TT, DM, DFF}; pg8::OrderDown1 S; S.init(G, bid); pg8::EpiResid E{x, ctx, a.out, (float*)(ws + WS_PART), mod + 2 * DM, 0.5f};
      pg8::gemm_phase<pg8::EpiResid, pg8::OrderDown1>(ldsl, g, S, E); }
    }
    xcd_barrier(xb);

    if constexpr ((PHMASK >> 4) & 1) {
    norm_rows(a.out, a.out, mod, 3, 4, XN, TX, gw, NGW, lane);
    {
        const float* part = (const float*)(ws + WS_PART); const float* g1 = mod + (size_t)4 * NMODW + 2 * DM; const float* sh = mod + (size_t)4 * NMODW + 3 * DM; const float* sc = mod + (size_t)4 * NMODW + 4 * DM;
        for (int r = NGW - 1 - gw; r < TC; r += NGW) {
            f32x4 v[8]; float ss = 0.f;
#pragma unroll
            for (int j = 0; j < 8; ++j) { const size_t o = (size_t)r * DM + 4 * lane + 256 * j;
                const f32x4 p = (*(const f32x4*)(part + o) + *(const f32x4*)(part + (size_t)TC * DM + o)) + (*(const f32x4*)(part + (size_t)2 * TC * DM + o) + *(const f32x4*)(part + (size_t)3 * TC * DM + o));
                v[j] = *(const f32x4*)(ctx + o) + *(const f32x4*)(g1 + 4 * lane + 256 * j) * 0.5f * p;
                ss += v[j].x * v[j].x + v[j].y * v[j].y + v[j].z * v[j].z + v[j].w * v[j].w; }
            const float rstd = rsqrtf(wave_sum(ss) * (1.f / DM) + NEPS);
#pragma unroll
            for (int j = 0; j < 8; ++j) { const int col = 4 * lane + 256 * j; const f32x4 s4 = *(const f32x4*)(sc + col), h4 = *(const f32x4*)(sh + col);
                const f32x4 o = v[j] * rstd * (s4 + 1.f) + h4; u32x2 w; w.x = pk2(o.x, o.y); w.y = pk2(o.z, o.w);
                *(u32x2*)(XN + (size_t)(TX + r) * DM + col) = w; }
        }
    }
    }
    xcd_barrier(xb);

    if constexpr ((PHMASK >> 5) & 1) {
    { pg8::Gemm g{XN, WIN, TT, PW, DM}; pg8::StaticOrder S; S.init(TT, PW, DM, G, bid); pg8::EpiProj E{ws};
      pg8::gemm_phase<pg8::EpiProj, pg8::StaticOrder>(ldsl, g, S, E); }
    }
    xcd_barrier(xb);

    bf16_t* QA = (bf16_t*)(ws + WS_QA); bf16_t* KA = (bf16_t*)(ws + WS_KA); bf16_t* VA = (bf16_t*)(ws + WS_VA); bf16_t* QR = (bf16_t*)(ws + WS_QR);
    bf16_t* KR = (bf16_t*)(ws + WS_KR); bf16_t* VR = (bf16_t*)(ws + WS_VR); bf16_t* GR = (bf16_t*)(ws + WS_GR); bf16_t* GA = (bf16_t*)(ws + WS_GA); bf16_t* GB = (bf16_t*)(ws + WS_GB);
    bf16_t* KVF = (bf16_t*)(ws + WS_KVF); bf16_t* KVB = (bf16_t*)(ws + WS_KVB);
    const float* dlog = a.in[11];
    constexpr float LOG2E = 1.4426950408889634f;

    if constexpr ((PHMASK >> 6) & 1) {
    {
        const float* qg = a.in[9]; const float* kg = a.in[10];
        f32x2_t* tab = (f32x2_t*)(lds + 69632);
        for (int i = tid; i < 128 * 32; i += 512) { const float invf = exp2f(-(float)(2 * (i & 31)) * (13.287712379549449f / 64.f)); float sn, cs; sincosf((float)(i >> 5) * invf, &sn, &cs); tab[i] = (f32x2_t){cs, sn}; }
        __syncthreads();
        float qgl[16], kgl[4];
#pragma unroll
        for (int i = 0; i < 16; ++i) qgl[i] = qg[(lane & 7) * 16 + i] * (att::SCALE * 1.4426950408889634f);
#pragma unroll
        for (int i = 0; i < 4; ++i) kgl[i] = kg[(lane & 31) * 4 + i];
        const bool qrowpos = (lane & 7) < 4, krowpos = (lane & 31) < 16;
        const int qf0 = ((lane & 7) * 8) & 31, kf0 = ((lane & 31) * 2) & 31;
        for (int r = gw; r < TT; r += NGW) {
            const bool isx = r < TX;
            u32x2* kp = (u32x2*)(KA + (size_t)r * 256) + lane; const u32x2 kw = *kp;
            u32x4* qp = (u32x4*)(QA + (size_t)r * 1024) + 2 * lane; u32x4 q0 = {0, 0, 0, 0}, q1 = {0, 0, 0, 0};
            if (isx) { q0 = qp[0]; q1 = qp[1]; }
            const int t = r & (SEQ - 1), prow = t >> 6, pcol = t & 63;
            {
                float xv[4] = {bflo(kw.x), bfhi(kw.x), bflo(kw.y), bfhi(kw.y)};
                float ss = xv[0] * xv[0] + xv[1] * xv[1] + xv[2] * xv[2] + xv[3] * xv[3];
                ss += __shfl_xor(ss, 1); ss += __shfl_xor(ss, 2); ss += __shfl_xor(ss, 4); ss += __shfl_xor(ss, 8); ss += __shfl_xor(ss, 16);
                const float rstd = rsqrtf(ss * (1.f / 128.f) + NEPS);
                unsigned ow[2];
#pragma unroll
                for (int p = 0; p < 2; ++p) { f32x2_t c = {1.f, 0.f}; if (isx) c = tab[(krowpos ? prow : pcol) * 32 + kf0 + p];
                    const float x0 = xv[2 * p] * rstd * kgl[2 * p], x1 = xv[2 * p + 1] * rstd * kgl[2 * p + 1]; ow[p] = pk2(x0 * c.x - x1 * c.y, x0 * c.y + x1 * c.x); }
                u32x2 o; o.x = ow[0]; o.y = ow[1]; *kp = o;
            }
            if (isx) {
                const unsigned qw[8] = {q0.x, q0.y, q0.z, q0.w, q1.x, q1.y, q1.z, q1.w};
                float ss = 0.f;
#pragma unroll
                for (int p = 0; p < 8; ++p) ss += bflo(qw[p]) * bflo(qw[p]) + bfhi(qw[p]) * bfhi(qw[p]);
                ss += __shfl_xor(ss, 1); ss += __shfl_xor(ss, 2); ss += __shfl_xor(ss, 4);
                const float rstd = rsqrtf(ss * (1.f / 128.f) + NEPS);
                const f32x2_t* tp = tab + (qrowpos ? prow : pcol) * 32 + qf0;
                unsigned ow[8];
#pragma unroll
                for (int p = 0; p < 8; ++p) { const f32x2_t c = tp[p]; const float x0 = bflo(qw[p]) * rstd * qgl[2 * p], x1 = bfhi(qw[p]) * rstd * qgl[2 * p + 1]; ow[p] = pk2(x0 * c.x - x1 * c.y, x0 * c.y + x1 * c.x); }
                u32x4 o0 = {ow[0], ow[1], ow[2], ow[3]}, o1 = {ow[4], ow[5], ow[6], ow[7]}; qp[0] = o0; qp[1] = o1;
            }
        }
        __syncthreads();
        for (int u = bid; u < NB * 8 * NEC; u += G) {
            const int e = u % NEC, bh = u / NEC, b = bh >> 3, h = bh & 7;
            const size_t row0 = e < 2 ? (size_t)TX + b * CTX + e * 128 : (size_t)b * SEQ + (e - 2) * 128;
            const float lf = dlog[h], lb = dlog[8 + h];
            const float lgf2 = -log1pf(expf(-lf)) * LOG2E, lgb2 = -log1pf(expf(-lb)) * LOG2E;
            att::kv_unit((char*)lds, KR + row0 * 1024 + h * 128, VR + row0 * 1024 + h * 128, KVF + ((size_t)bh * NEC + e) * 16384, KVB + ((size_t)bh * NEC + e) * 16384, lgf2, lgb2);
        }
    }
    }
    xcd_barrier(xb);

    if constexpr ((PHMASK >> 7) & 1) {
    for (int task = bid * 512 + tid; task < 64 * 2048; task += G * 512) {
        const int el = (task & 2047) * 8, bhd = task >> 11, dir = bhd & 1, bh = bhd >> 1, h = bh & 7;
        const float lg = dlog[dir * 8 + h]; const float cd = exp2f(128.f * (-log1pf(expf(-lg)) * LOG2E));
        bf16_t* base = (dir ? KVB : KVF) + (size_t)bh * NEC * 16384 + el;
        float S[8];
#pragma unroll
        for (int i = 0; i < 8; ++i) S[i] = 0.f;
        auto ord = [&](int q) { return dir ? (q == 0 ? 1 : q == 1 ? 0 : NEC + 1 - q) : q; };
        for (int s0 = 0; s0 < NEC; s0 += 6) {
            u32x4 cv[6];
#pragma unroll
            for (int i = 0; i < 6; ++i) cv[i] = *(const u32x4*)(base + (size_t)ord(s0 + i) * 16384);
#pragma unroll
            for (int i = 0; i < 6; ++i) {
                const u32x4 cur = cv[i];
                u32x4 o; o.x = pk2(S[0], S[1]); o.y = pk2(S[2], S[3]); o.z = pk2(S[4], S[5]); o.w = pk2(S[6], S[7]);
                *(u32x4*)(base + (size_t)ord(s0 + i) * 16384) = o;
                S[0] = cd * S[0] + bflo(cur.x); S[1] = cd * S[1] + bfhi(cur.x); S[2] = cd * S[2] + bflo(cur.y); S[3] = cd * S[3] + bfhi(cur.y);
                S[4] = cd * S[4] + bflo(cur.z); S[5] = cd * S[5] + bfhi(cur.z); S[6] = cd * S[6] + bflo(cur.w); S[7] = cd * S[7] + bfhi(cur.w);
            }
        }
    }
    }
    xcd_barrier(xb);

    if constexpr ((PHMASK >> 8) & 1) {
#pragma unroll 1
    for (int pass = 0; pass < 2; ++pass) {
    const bool do_ret = (pass == 0) != (((bid >> 3) & 1) != 0);
    if (do_ret)
    for (int u = bid; u < NB * 8 * 32; u += G) {
        const int blk = u & 31, bh = u >> 5, b = bh >> 3, h = bh & 7;
        const size_t row0 = (size_t)b * SEQ + blk * 256;
        const float lf = dlog[h], lb = dlog[8 + h];
        const float lgf2 = -log1pf(expf(-lf)) * LOG2E, lgb2 = -log1pf(expf(-lb)) * LOG2E;
        const size_t so = ((size_t)bh * NEC + 2 + 2 * blk) * 16384;
        att::ret_unit((char*)lds, QR + row0 * 1024 + h * 128, KR + row0 * 1024 + h * 128, VR + row0 * 1024 + h * 128, GR + row0 * 1024 + h * 128, QR + row0 * 1024 + h * 128,
                      KVF + so, KVB + so, lgf2, lgb2);
    }
    else
    for (int u = bid; u < NB * 8 * 32; u += G) {
        const int xc = u & 7, rest = u >> 3, g = rest >> 5, qb = rest & 31, b = xc >> 1, kvh = xc & 1, hq = kvh * 4 + g;
        const size_t qrow = (size_t)b * SEQ + qb * 256;
        att::attn_unit(QA + qrow * 1024 + hq * 128, KA + ((size_t)TX + b * CTX) * 256 + kvh * 128, KA + (size_t)b * SEQ * 256 + kvh * 128,
                       VA + ((size_t)TX + b * CTX) * 256 + kvh * 128, VA + (size_t)b * SEQ * 256 + kvh * 128, QA + qrow * 1024 + hq * 128, (char*)lds);
    }
    }
    }
    xcd_barrier(xb);

    if constexpr ((PHMASK >> 9) & 1) {
    { pg8::Gemm g{QA, WPA, TX, DM, 1024}; pg8::StaticOrder S; S.init(TX, DM, 1024, G, bid); pg8::EpiMerge<0> E{GA, GB};
      pg8::gemm_phase<pg8::EpiMerge<0>, pg8::StaticOrder>(ldsl, g, S, E); }
    { pg8::Gemm g{QR, WPR, TX, DM, 1024}; pg8::StaticOrder S; S.init(TX, DM, 1024, G, bid); pg8::EpiMerge<1> E{GA, GB};
      pg8::gemm_phase<pg8::EpiMerge<1>, pg8::StaticOrder>(ldsl, g, S, E); }
    }
    xcd_barrier(xb);

    if constexpr ((PHMASK >> 10) & 1) {
    { pg8::Gemm g{GA, WO, TX, DM, DM}; pg8::StaticOrder S; S.init(TX, DM, DM, G, bid); pg8::EpiResid E{a.out, a.out, a.out, a.out, mod + 5 * DM, 1.0f};
      pg8::gemm_phase<pg8::EpiResid, pg8::StaticOrder>(ldsl, g, S, E); }
    }
    xcd_barrier(xb);

    if constexpr ((PHMASK >> 11) & 1) {
    norm_rows(a.out, a.out, mod, 6, 7, XN, TX, gw, NGW, lane);
    }
    xcd_barrier(xb);

    if constexpr ((PHMASK >> 12) & 1) {
    { pg8::Gemm g{XN, W3, TX, 2 * DFF, DM}; pg8::StaticOrder S; S.init(TX, 2 * DFF, DM, G, bid); pg8::EpiSwiglu E{HID};
      pg8::gemm_phase<pg8::EpiSwiglu, pg8::StaticOrder>(ldsl, g, S, E); }
    }
    xcd_barrier(xb);

    if constexpr ((PHMASK >> 13) & 1) {
    { pg8::Gemm g{HID, W4, TX, DM, DFF}; pg8::StaticOrder S; S.init(TX, DM, DFF, G, bid); pg8::EpiResid E{a.out, a.out, a.out, a.out, mod + 8 * DM, 0.5f};
      pg8::gemm_phase<pg8::EpiResid, pg8::StaticOrder>(ldsl, g, S, E); }
    }
    xcd_barrier(xb);

    if constexpr ((PHMASK >> 14) & 1) {
    {
        const float* fn = a.in[17];
        for (int r = gw; r < TX; r += NGW) {
            float* row = a.out + (size_t)r * DM; f32x4 v[8]; float ss = 0.f;
#pragma unroll
            for (int j = 0; j < 8; ++j) { v[j] = ((const f32x4*)row)[lane + 64 * j]; ss += v[j].x * v[j].x + v[j].y * v[j].y + v[j].z * v[j].z + v[j].w * v[j].w; }
            const float rstd = rsqrtf(wave_sum(ss) * (1.f / DM) + NEPS);
#pragma unroll
            for (int j = 0; j < 8; ++j) { const f32x4 f4 = ((const f32x4*)fn)[lane + 64 * j]; ((f32x4*)row)[lane + 64 * j] = v[j] * rstd * f4; }
        }
    }
    }
}

extern "C" void kernel_launch(void* const* d_in, const int* in_sizes, int n_in, void* d_out, int out_size, void* d_ws, size_t ws_size, hipStream_t stream) {
    static int grid = 0;
    if (grid == 0) {
        int dev = 0, cus = 0, per_cu = 0;
        (void)hipGetDevice(&dev);
        (void)hipDeviceGetAttribute(&cus, hipDeviceAttributeMultiprocessorCount, dev);
        if (hipFuncSetAttribute((const void*)mega_fwd, hipFuncAttributeMaxDynamicSharedMemorySize, LDS_BYTES) != hipSuccess) fprintf(stderr, "kernel_launch: hipFuncSetAttribute failed\n");
        (void)hipOccupancyMaxActiveBlocksPerMultiprocessor(&per_cu, (const void*)mega_fwd, 512, LDS_BYTES);
        if (ws_size < WS_END || n_in != 18) { fprintf(stderr, "kernel_launch: workspace %zu < %zu or n_in %d != 18\n", ws_size, (size_t)WS_END, n_in); grid = -1; return; }
        if (per_cu < 1) fprintf(stderr, "kernel_launch: occupancy query says %d blocks per CU\n", per_cu);
        grid = cus > 0 ? cus : 256;
    }
    if (grid < 0) return;
    Args a{};
    for (int i = 0; i < 18; ++i) a.in[i] = (const float*)d_in[i];
    a.out = (float*)d_out; a.ws = (unsigned char*)d_ws;
    void* args[] = {&a};
    hipError_t e = hipLaunchCooperativeKernel((const void*)mega_fwd, dim3(grid), dim3(512), args, LDS_BYTES, stream);
    if (e != hipSuccess) fprintf(stderr, "kernel_launch: cooperative launch failed: %s (grid %d)\n", hipGetErrorString(e), grid);
}
```

```cpp
#include <hip/hip_runtime.h>
#include <hip/hip_cooperative_groups.h>
#include <cstdio>
#include <cstdint>
namespace cg = cooperative_groups;

constexpr int NB = 4, SEQ = 8192, DM = 2048, CTX = 256, TX = NB * SEQ, TC = NB * CTX, TT = TX + TC;
constexpr int DFF = 5632, PW = 9728, NMODW = 9 * DM;
constexpr int NCH = SEQ / 128, NEC = NCH + 2;
constexpr float NEPS = 1e-6f;

typedef unsigned short bf16_t;
typedef short bf16x8 __attribute__((ext_vector_type(8)));
typedef short s16x4 __attribute__((ext_vector_type(4)));
typedef float f32x4 __attribute__((ext_vector_type(4)));
typedef float f32x16 __attribute__((ext_vector_type(16)));
typedef unsigned u32x4 __attribute__((ext_vector_type(4)));
typedef unsigned u32x2 __attribute__((ext_vector_type(2)));
typedef float f32x2_t __attribute__((ext_vector_type(2)));
typedef __bf16 bf16x2_t __attribute__((ext_vector_type(2)));

constexpr size_t MiB = 1u << 20;
constexpr size_t WS_MOD = 0;
constexpr size_t WS_HC = 1 * MiB;
constexpr size_t WS_W1 = 9 * MiB;
constexpr size_t WS_W2 = 53 * MiB;
constexpr size_t WS_WIN = 75 * MiB;
constexpr size_t WS_WPA = 113 * MiB;
constexpr size_t WS_WPR = 117 * MiB;
constexpr size_t WS_WO = 121 * MiB;
constexpr size_t WS_W3 = 129 * MiB;
constexpr size_t WS_W4 = 173 * MiB;
constexpr size_t WS_XN = 195 * MiB;
constexpr size_t WS_KVF = WS_XN, WS_KVB = WS_XN + 66 * MiB;
constexpr size_t WS_R = 327 * MiB;
constexpr size_t WS_QA = WS_R, WS_KA = WS_R + 66 * MiB, WS_VA = WS_KA + 33 * MiB / 2, WS_QR = WS_R + 99 * MiB, WS_KR = WS_R + 165 * MiB,
                 WS_VR = WS_R + 231 * MiB, WS_GR = WS_R + 297 * MiB, WS_GA = WS_R + 363 * MiB, WS_GB = WS_R + 495 * MiB, WS_END = WS_R + 627 * MiB;
constexpr size_t WS_PART = WS_R + 400 * MiB;
constexpr int LDS_BYTES = 147456;

#define DI __device__ __forceinline__
DI unsigned f2bf(float f) { unsigned u = __builtin_bit_cast(unsigned, f); return (u + 0x7fffu + ((u >> 16) & 1u)) >> 16; }
DI unsigned pk2(float lo, float hi) { f32x2_t v = {lo, hi}; bf16x2_t b = __builtin_convertvector(v, bf16x2_t); return __builtin_bit_cast(unsigned, b); }
DI float bflo(unsigned w) { return __builtin_bit_cast(float, w << 16); }
DI float bfhi(unsigned w) { return __builtin_bit_cast(float, w & 0xffff0000u); }
DI float wave_sum(float v) {
#pragma unroll
    for (int o = 1; o < 64; o <<= 1) v += __shfl_xor(v, o);
    return v;
}
DI float sigmoidf_(float x) { return __builtin_amdgcn_rcpf(1.f + __expf(-x)); }
DI float siluf_(float x) { return x * sigmoidf_(x); }
#define LDS_WAIT() asm volatile("s_waitcnt lgkmcnt(0)" ::: "memory")

namespace pg8 {
#define PG8_LAS __attribute__((address_space(3)))
constexpr int BM = 256, BK = 64, HALF = 128, HTB = HALF * BK * 2, STAGE_BYTES = 8 * HTB, NXCD = 8, WGM = 8;
__host__ __device__ __forceinline__ int lds_byte(int r, int c) { const int st = (r >> 4) * 2 + (c >> 5), rr = r & 15, cc = c & 31, ob = rr * 64 + cc * 2; return st * 1024 + (ob ^ (((ob >> 9) & 1) << 5)); }
__host__ __device__ __forceinline__ void stage_rc(int b, int& R, int& C) { const int st = b / 1024, sb = b % 1024, swz = sb ^ (((sb >> 9) & 1) << 5); R = (st >> 1) * 16 + swz / 64; C = (st & 1) * 32 + (swz % 64) / 2; }
__host__ __device__ __forceinline__ int perm32(int rho) { const int n = rho >> 4, i = rho & 15; return 8 * (i >> 2) + 4 * n + (i & 3); }
struct Unit { int pm, pn, kt0, nt; };
struct Gemm { const bf16_t* A; const bf16_t* Bt; int M, N, K; };
struct StaticOrder {
    int nM, nN, nwg, G, c, ntk, wgm;
    __host__ __device__ void init(int M, int N, int K, int G_, int c_) { nM = M / BM; nN = N / BM; nwg = nM * nN; G = G_; c = c_; ntk = K / BK; wgm = (nN <= 8) ? 4 : WGM; }
    __host__ __device__ bool next(int i, Unit& u) const {
        const long L = (long)i * G + c; if (L >= nwg) return false;
        int wgid = (int)L; { const int q = nwg / NXCD, r = nwg % NXCD, xcd = wgid % NXCD, off = wgid / NXCD; wgid = (xcd < r ? xcd * (q + 1) : r * (q + 1) + (xcd - r) * q) + off; }
        const int nig = wgm * nN, gid = wgid / nig, fm = gid * wgm, gsz = (nM - fm) < wgm ? (nM - fm) : wgm;
        u.pm = fm + ((wgid % nig) % gsz); u.pn = (wgid % nig) / gsz; u.kt0 = 0; u.nt = ntk; return true;
    }
};
struct OrderDown1 {
    StaticOrder lat; int G, c;
    __host__ __device__ void init(int G_, int c_) { lat.init(TX, DM, DFF, G_, c_); G = G_; c = c_; }
    __host__ __device__ bool next(int i, Unit& u) const {
        const long L = (long)i * G + c; if (L < lat.nwg) return lat.next(i, u);
        const int j = (int)(L - lat.nwg); if (j >= 128) return false;
        u.kt0 = (j & 3) * 22; u.nt = 22; u.pn = (j >> 2) & 7; u.pm = TX / BM + (j >> 5); return true;
    }
};
template <class Epi, class Sched>
__device__ __forceinline__ void gemm_phase(PG8_LAS unsigned char* lds, const Gemm g, const Sched& S, const Epi& E) {
    int tid = threadIdx.x; asm volatile("" : "+v"(tid));
    const int wid = __builtin_amdgcn_readfirstlane(tid >> 6), lane = tid & 63, wr = wid >> 2, wc = wid & 3, fr = lane & 15, fq = lane >> 4;
    const int K = g.K;
    unsigned voffA[2], voffB[2];
#pragma unroll
    for (int i = 0; i < 2; ++i) { int R, C; stage_rc(tid * 16 + i * 8192, R, C); const int Rb = Epi::PERM ? ((R & ~31) + perm32(R & 31)) : R;
        voffA[i] = (unsigned)(R * K + C) * 2u; voffB[i] = (unsigned)(Rb * K + C) * 2u; }
    const size_t kstep = (size_t)(BK * 2);
    const size_t hstep = (size_t)HALF * K * 2;
    const size_t tstep = 2 * hstep;
    const unsigned ldsw = (unsigned)wid * 1024u;
    const int aoff = lds_byte(wr * 64 + fr, fq * 8), boff = lds_byte(wc * 32 + fr, fq * 8);
#define PG8_SA(b, h) (((b) * 2 + (h)) * HTB)
#define PG8_SB(b, h) ((4 + (b) * 2 + (h)) * HTB)
#define PG8_STAGE(bufoff, gbase, voff) do { _Pragma("unroll") for (int _i = 0; _i < 2; ++_i) \
        __builtin_amdgcn_global_load_lds((const unsigned*)((const char*)(gbase) + (voff)[_i]), (PG8_LAS unsigned*)(lds + (bufoff) + ldsw + _i * 8192), 16, 0, 0); } while (0)
#define PG8_LDA(dst, b, h) do { _Pragma("unroll") for (int m = 0; m < 4; ++m) _Pragma("unroll") for (int k = 0; k < 2; ++k) dst[m][k] = *(const PG8_LAS bf16x8*)(lds + PG8_SA(b, h) + aoff + m * 2048 + k * 1024); } while (0)
#define PG8_LDB(dst, b, h) do { _Pragma("unroll") for (int n = 0; n < 2; ++n) _Pragma("unroll") for (int k = 0; k < 2; ++k) dst[n][k] = *(const PG8_LAS bf16x8*)(lds + PG8_SB(b, h) + boff + n * 2048 + k * 1024); } while (0)
#define PG8_MMA(ai, bj, At, Bt) do { __builtin_amdgcn_s_setprio(1); _Pragma("unroll") for (int m = 0; m < 4; ++m) _Pragma("unroll") for (int n = 0; n < 2; ++n) _Pragma("unroll") for (int k = 0; k < 2; ++k) \
        acc[ai][bj][m][n] = __builtin_amdgcn_mfma_f32_16x16x32_bf16(Bt[n][k], At[m][k], acc[ai][bj][m][n], 0, 0, 0); __builtin_amdgcn_s_setprio(0); } while (0)
#define PG8_WAIT_V(n) asm volatile("s_waitcnt vmcnt(" #n ")" ::: "memory")
#define PG8_WAIT_L(n) asm volatile("s_waitcnt lgkmcnt(" #n ")" ::: "memory")
#define PG8_BAR __builtin_amdgcn_s_barrier()
#define PG8_SCHED __builtin_amdgcn_sched_barrier(0)
    Unit cur, nxt; int ui = 0;
    if (!S.next(0, cur)) return;
    f32x4 acc[2][2][4][2];
#pragma unroll
    for (int a = 0; a < 2; ++a)
#pragma unroll
        for (int b = 0; b < 2; ++b)
#pragma unroll
            for (int m = 0; m < 4; ++m)
#pragma unroll
                for (int n = 0; n < 2; ++n) acc[a][b][m][n] = (f32x4){0.f, 0.f, 0.f, 0.f};
    bf16x8 At[4][2], B0[2][2], B1[2][2];
    const char* cA = (const char*)g.A + (size_t)cur.pm * tstep + (size_t)cur.kt0 * kstep; const char* cB = (const char*)g.Bt + (size_t)cur.pn * tstep + (size_t)cur.kt0 * kstep;
    {
        PG8_STAGE(PG8_SB(0, 0), cB, voffB); PG8_STAGE(PG8_SB(0, 1), cB + hstep, voffB); PG8_STAGE(PG8_SA(0, 0), cA, voffA); PG8_STAGE(PG8_SA(0, 1), cA + hstep, voffA);
        if (wr == 1) PG8_BAR;
        PG8_WAIT_V(2); PG8_BAR;
        PG8_STAGE(PG8_SB(1, 0), cB + kstep, voffB); PG8_STAGE(PG8_SA(1, 0), cA + kstep, voffA); PG8_STAGE(PG8_SB(1, 1), cB + hstep + kstep, voffB);
        PG8_WAIT_V(6); PG8_BAR;
    }
    for (;;) {
        const bool has_next = S.next(ui + 1, nxt);
        const char* nA = has_next ? (const char*)g.A + (size_t)nxt.pm * tstep + (size_t)nxt.kt0 * kstep : cA; const char* nB = has_next ? (const char*)g.Bt + (size_t)nxt.pn * tstep + (size_t)nxt.kt0 * kstep : cB;
        const int nt = cur.nt;
        for (int t = 0; t < nt; t += 2) {
            const bool last = (t == nt - 2);
            const char* a1 = cA + (size_t)(t + 1) * kstep;
            const char* a2 = last ? nA : cA + (size_t)(t + 2) * kstep; const char* b2 = last ? nB : cB + (size_t)(t + 2) * kstep;
            const char* a3 = a2 + kstep; const char* b3 = b2 + kstep;
            PG8_LDB(B0, 0, 0); PG8_LDB(B1, 0, 1); PG8_SCHED; PG8_LDA(At, 0, 0); PG8_STAGE(PG8_SA(1, 1), a1 + hstep, voffA);
            PG8_WAIT_V(8); PG8_WAIT_L(0); PG8_BAR; PG8_MMA(0, 0, At, B0); PG8_MMA(0, 1, At, B1); PG8_BAR; PG8_SCHED;
            PG8_LDA(At, 0, 1); PG8_STAGE(PG8_SB(0, 0), b2, voffB); PG8_STAGE(PG8_SB(0, 1), b2 + hstep, voffB); PG8_STAGE(PG8_SA(0, 0), a2, voffA);
            PG8_WAIT_V(8); PG8_WAIT_L(0); PG8_BAR; PG8_MMA(1, 0, At, B0); PG8_MMA(1, 1, At, B1); PG8_BAR; PG8_SCHED;
            PG8_LDB(B0, 1, 0); PG8_LDB(B1, 1, 1); PG8_SCHED; PG8_LDA(At, 1, 0); PG8_STAGE(PG8_SA(0, 1), a2 + hstep, voffA);
            PG8_WAIT_V(8); PG8_WAIT_L(0); PG8_BAR; PG8_MMA(0, 0, At, B0); PG8_MMA(0, 1, At, B1); PG8_BAR; PG8_SCHED;
            PG8_LDA(At, 1, 1); PG8_STAGE(PG8_SB(1, 0), b3, voffB); PG8_STAGE(PG8_SB(1, 1), b3 + hstep, voffB); PG8_STAGE(PG8_SA(1, 0), a3, voffA);
            PG8_WAIT_V(8); PG8_WAIT_L(0); PG8_BAR; PG8_MMA(1, 0, At, B0); PG8_MMA(1, 1, At, B1); PG8_BAR; PG8_SCHED;
        }
        if (wr == 0) PG8_BAR;
        E(acc, cur, wr, wc, fr, fq);
        if (!has_next) break;
#pragma unroll
        for (int a = 0; a < 2; ++a)
#pragma unroll
            for (int b = 0; b < 2; ++b)
#pragma unroll
                for (int m = 0; m < 4; ++m)
#pragma unroll
                    for (int n = 0; n < 2; ++n) acc[a][b][m][n] = (f32x4){0.f, 0.f, 0.f, 0.f};
        cur = nxt; cA = nA; cB = nB; ++ui;
        if (wr == 1) PG8_BAR;
    }
    PG8_WAIT_V(0);
    PG8_BAR;
#undef PG8_SA
#undef PG8_SB
#undef PG8_STAGE
#undef PG8_LDA
#undef PG8_LDB
#undef PG8_MMA
#undef PG8_WAIT_V
#undef PG8_WAIT_L
#undef PG8_BAR
#undef PG8_SCHED
}

struct EpiSwiglu {
    static constexpr bool PERM = true;
    bf16_t* O;
    __device__ __forceinline__ void operator()(const f32x4 (&acc)[2][2][4][2], const Unit& u, int wr, int wc, int fr, int fq) const {
        const int row0 = u.pm * BM + wr * 64 + fr; const int col0 = u.pn * HALF + wc * 32 + 8 * fq;
#pragma unroll
        for (int ai = 0; ai < 2; ++ai)
#pragma unroll
            for (int m = 0; m < 4; ++m) {
                bf16_t* rowp = O + (size_t)(row0 + ai * HALF + m * 16) * DFF + col0;
                const f32x4 a0 = acc[ai][0][m][0], a1 = acc[ai][0][m][1], b0 = acc[ai][1][m][0], b1 = acc[ai][1][m][1];
                u32x4 w;
                w.x = pk2(siluf_(a0[0]) * b0[0], siluf_(a0[1]) * b0[1]); w.y = pk2(siluf_(a0[2]) * b0[2], siluf_(a0[3]) * b0[3]);
                w.z = pk2(siluf_(a1[0]) * b1[0], siluf_(a1[1]) * b1[1]); w.w = pk2(siluf_(a1[2]) * b1[2], siluf_(a1[3]) * b1[3]);
                *(u32x4*)rowp = w;
            }
    }
};
struct EpiResid {
    static constexpr bool PERM = false;
    const float* basex; const float* basec; float* outx; float* outc; const float* gate; float scale;
    __device__ __forceinline__ void operator()(const f32x4 (&acc)[2][2][4][2], const Unit& u, int wr, int wc, int fr, int fq) const {
        const bool isx = u.pm < TX / BM;
        const int col0 = u.pn * BM + wc * 32 + 4 * fq;
        if (!isx) {
            float* po = outc + ((size_t)(u.kt0 / 22) * TC + (size_t)(u.pm - TX / BM) * BM) * DM;
#pragma unroll
            for (int ai = 0; ai < 2; ++ai)
#pragma unroll
                for (int m = 0; m < 4; ++m) { const size_t off = (size_t)(wr * 64 + ai * HALF + m * 16 + fr) * DM + col0;
#pragma unroll
                    for (int bj = 0; bj < 2; ++bj)
#pragma unroll
                        for (int n = 0; n < 2; ++n) *(f32x4*)(po + off + bj * HALF + n * 16) = acc[ai][bj][m][n]; }
            return;
        }
        const int bidx = u.pm >> 5;
        const float* base = basex + (size_t)u.pm * BM * DM;
        float* out = outx + (size_t)u.pm * BM * DM;
        f32x4 gv[2][2];
#pragma unroll
        for (int bj = 0; bj < 2; ++bj)
#pragma unroll
            for (int n = 0; n < 2; ++n) gv[bj][n] = *(const f32x4*)(gate + (size_t)bidx * NMODW + col0 + bj * HALF + n * 16) * scale;
#pragma unroll
        for (int ai = 0; ai < 2; ++ai)
#pragma unroll
            for (int m = 0; m < 4; ++m) { const size_t off = (size_t)(wr * 64 + ai * HALF + m * 16 + fr) * DM + col0;
#pragma unroll
                for (int bj = 0; bj < 2; ++bj)
#pragma unroll
                    for (int n = 0; n < 2; ++n) { const f32x4 bs = *(const f32x4*)(base + off + bj * HALF + n * 16);
                        *(f32x4*)(out + off + bj * HALF + n * 16) = bs + gv[bj][n] * acc[ai][bj][m][n]; } }
    }
};
struct EpiProj {
    static constexpr bool PERM = true;
    unsigned char* ws;
    __device__ __forceinline__ void operator()(const f32x4 (&acc)[2][2][4][2], const Unit& u, int wr, int wc, int fr, int fq) const {
        const int pn = u.pn; size_t boff; int ldc, ct; float sc = 1.f;
        if (pn < 4) { boff = WS_QA; ldc = 1024; ct = pn; }
        else if (pn < 5) { boff = WS_KA; ldc = 256; ct = 0; }
        else if (pn < 6) { boff = WS_VA; ldc = 256; ct = 0; }
        else if (pn < 10) { boff = WS_QR; ldc = 1024; ct = pn - 6; }
        else if (pn < 14) { boff = WS_KR; ldc = 1024; ct = pn - 10; sc = 0.08838834764831845f; }
        else if (pn < 18) { boff = WS_VR; ldc = 1024; ct = pn - 14; }
        else if (pn < 22) { boff = WS_GR; ldc = 1024; ct = pn - 18; }
        else if (pn < 30) { boff = WS_GA; ldc = 2048; ct = pn - 22; }
        else { boff = WS_GB; ldc = 2048; ct = pn - 30; }
        bf16_t* O = (bf16_t*)(ws + boff);
        const int row0 = u.pm * BM + wr * 64 + fr; const int col0 = ct * BM + wc * 32 + 8 * fq;
#pragma unroll
        for (int ai = 0; ai < 2; ++ai)
#pragma unroll
            for (int m = 0; m < 4; ++m) { bf16_t* rowp = O + (size_t)(row0 + ai * HALF + m * 16) * ldc + col0;
#pragma unroll
                for (int bj = 0; bj < 2; ++bj) { const f32x4 v0 = acc[ai][bj][m][0] * sc, v1 = acc[ai][bj][m][1] * sc;
                    u32x4 w; w.x = pk2(v0[0], v0[1]); w.y = pk2(v0[2], v0[3]); w.z = pk2(v1[0], v1[1]); w.w = pk2(v1[2], v1[3]);
                    *(u32x4*)(rowp + bj * HALF) = w; } }
    }
};
template <int MODE> struct EpiMerge {
    static constexpr bool PERM = true;
    bf16_t* GA; const bf16_t* GB;
    __device__ __forceinline__ void operator()(const f32x4 (&acc)[2][2][4][2], const Unit& u, int wr, int wc, int fr, int fq) const {
        const int row0 = u.pm * BM + wr * 64 + fr; const int col0 = u.pn * BM + wc * 32 + 8 * fq;
#pragma unroll
        for (int ai = 0; ai < 2; ++ai)
#pragma unroll
            for (int m = 0; m < 4; ++m) { const size_t off = (size_t)(row0 + ai * HALF + m * 16) * DM + col0;
#pragma unroll
                for (int bj = 0; bj < 2; ++bj) { const f32x4 v0 = acc[ai][bj][m][0], v1 = acc[ai][bj][m][1];
                    const u32x4 ga = *(const u32x4*)(GA + off + bj * HALF); u32x4 w;
                    if (MODE == 0) {
                        w.x = pk2(sigmoidf_(bflo(ga.x)) * v0[0], sigmoidf_(bfhi(ga.x)) * v0[1]); w.y = pk2(sigmoidf_(bflo(ga.y)) * v0[2], sigmoidf_(bfhi(ga.y)) * v0[3]);
                        w.z = pk2(sigmoidf_(bflo(ga.z)) * v1[0], sigmoidf_(bfhi(ga.z)) * v1[1]); w.w = pk2(sigmoidf_(bflo(ga.w)) * v1[2], sigmoidf_(bfhi(ga.w)) * v1[3]);
                    } else {
                        const u32x4 gb = *(const u32x4*)(GB + off + bj * HALF);
                        w.x = pk2(bflo(ga.x) + sigmoidf_(bflo(gb.x)) * v0[0], bfhi(ga.x) + sigmoidf_(bfhi(gb.x)) * v0[1]); w.y = pk2(bflo(ga.y) + sigmoidf_(bflo(gb.y)) * v0[2], bfhi(ga.y) + sigmoidf_(bfhi(gb.y)) * v0[3]);
                        w.z = pk2(bflo(ga.z) + sigmoidf_(bflo(gb.z)) * v1[0], bfhi(ga.z) + sigmoidf_(bfhi(gb.z)) * v1[1]); w.w = pk2(bflo(ga.w) + sigmoidf_(bflo(gb.w)) * v1[2], bfhi(ga.w) + sigmoidf_(bfhi(gb.w)) * v1[3]);
                    }
                    *(u32x4*)(GA + off + bj * HALF) = w; } }
    }
};
}

namespace att {
constexpr int D = 128, NW = 8, QBLK = 32, KVBLK = 64;
constexpr float SCALE = 0.088388347648318440f;
constexpr float THR = 8.f;
constexpr size_t SHM_V = KVBLK * D * 2, SHM_K = KVBLK * D * 2;
#define KSWZ(row, colB) ((row) * 256 + ((colB) ^ (((row) & 7) << 4)))
#define SBAR() __builtin_amdgcn_sched_barrier(0)
DI int crow(int r, int hi) { return (r & 3) + 8 * (r >> 2) + 4 * hi; }
DI unsigned cvtpk(float lo, float hi) { return pk2(lo, hi); }
DI void partialSM(f32x16& p0, f32x16& p1, float& m_reg, float& mn, float& alpha) {
    constexpr float C = SCALE * 1.4426950408889634f;
    float pmax = p0[0];
#pragma unroll
    for (int r = 1; r < 16; ++r) pmax = fmaxf(pmax, p0[r]);
#pragma unroll
    for (int r = 0; r < 16; ++r) pmax = fmaxf(pmax, p1[r]);
    { auto rr = __builtin_amdgcn_permlane32_swap(__float_as_uint(pmax), __float_as_uint(pmax), false, false);
      pmax = fmaxf(__uint_as_float(rr[0]), __uint_as_float(rr[1])); }
    if (__builtin_expect(__all(pmax - m_reg <= THR / SCALE), 1)) { mn = m_reg; alpha = 1.f; }
    else { mn = fmaxf(m_reg, pmax); alpha = __builtin_amdgcn_exp2f((m_reg - mn) * C); m_reg = mn; }
    float mnC = -mn * C;
#pragma unroll
    for (int r = 0; r < 16; ++r) p0[r] = fmaf(p0[r], C, mnC);
#pragma unroll
    for (int r = 0; r < 16; ++r) p1[r] = fmaf(p1[r], C, mnC);
#pragma unroll
    for (int r = 0; r < 16; ++r) p0[r] = __builtin_amdgcn_exp2f(p0[r]);
}
#define PK4(P, BASE, OUT) do { unsigned a0 = cvtpk(P[BASE + 0], P[BASE + 1]), a1 = cvtpk(P[BASE + 2], P[BASE + 3]);   \
    unsigned b0 = cvtpk(P[BASE + 4], P[BASE + 5]), b1 = cvtpk(P[BASE + 6], P[BASE + 7]);                              \
    auto r0 = __builtin_amdgcn_permlane32_swap(a0, b0, false, false); auto r1 = __builtin_amdgcn_permlane32_swap(a1, b1, false, false); \
    u32x4 w = {r0[0], r1[0], r0[1], r1[1]}; OUT = __builtin_bit_cast(bf16x8, w); } while (0)
DI void finishSM(f32x16& p0, f32x16& p1, float alpha, float& l_reg, bf16x8& pa0, bf16x8& pa1, bf16x8& pa2, bf16x8& pa3) {
#pragma unroll
    for (int r = 0; r < 16; ++r) p1[r] = __builtin_amdgcn_exp2f(p1[r]);
    float ps = 0;
#pragma unroll
    for (int r = 0; r < 16; ++r) ps += p0[r];
#pragma unroll
    for (int r = 0; r < 16; ++r) ps += p1[r];
    { auto rr = __builtin_amdgcn_permlane32_swap(__float_as_uint(ps), __float_as_uint(ps), false, false);
      ps = __uint_as_float(rr[0]) + __uint_as_float(rr[1]); }
    l_reg = l_reg * alpha + ps;
    PK4(p0, 0, pa0); PK4(p0, 8, pa1); PK4(p1, 0, pa2); PK4(p1, 8, pa3);
}
DI void packP(const f32x16& p0, const f32x16& p1, bf16x8& pa0, bf16x8& pa1, bf16x8& pa2, bf16x8& pa3) {
    PK4(p0, 0, pa0); PK4(p0, 8, pa1); PK4(p1, 0, pa2); PK4(p1, 8, pa3);
}
DI void qkt(f32x16& p0, f32x16& p1, const char* Ks, const bf16x8* qr, int r32, int hi) {
    p0 = f32x16{}; p1 = f32x16{};
#pragma unroll
    for (int d0 = 0; d0 < 8; ++d0) { int cb = (d0 * 16 + hi * 8) * 2;
        bf16x8 b0 = *reinterpret_cast<const bf16x8*>(Ks + KSWZ(r32, cb));
        bf16x8 b1 = *reinterpret_cast<const bf16x8*>(Ks + KSWZ(32 + r32, cb));
        p0 = __builtin_amdgcn_mfma_f32_32x32x16_bf16(b0, qr[d0], p0, 0, 0, 0);
        p1 = __builtin_amdgcn_mfma_f32_32x32x16_bf16(b1, qr[d0], p1, 0, 0, 0); }
}
constexpr float THRL = THR * 1.4426950408889634f;
DI void qkt_m(f32x16& p0, f32x16& p1, const char* Ks, const bf16x8* qr, const f32x16& negm, int r32, int hi) {
#pragma unroll
    for (int d0 = 0; d0 < 8; ++d0) { int cb = (d0 * 16 + hi * 8) * 2;
        bf16x8 b0 = *reinterpret_cast<const bf16x8*>(Ks + KSWZ(r32, cb));
        bf16x8 b1 = *reinterpret_cast<const bf16x8*>(Ks + KSWZ(32 + r32, cb));
        if (d0 == 0) { p0 = __builtin_amdgcn_mfma_f32_32x32x16_bf16(b0, qr[0], negm, 0, 0, 0); p1 = __builtin_amdgcn_mfma_f32_32x32x16_bf16(b1, qr[0], negm, 0, 0, 0); }
        else { p0 = __builtin_amdgcn_mfma_f32_32x32x16_bf16(b0, qr[d0], p0, 0, 0, 0); p1 = __builtin_amdgcn_mfma_f32_32x32x16_bf16(b1, qr[d0], p1, 0, 0, 0); } }
}
DI void partialSM_m(f32x16& p0, f32x16& p1, float& m_reg, f32x16& negm, float& alpha) {
    float pmax = p0[0];
#pragma unroll
    for (int r = 1; r < 16; ++r) pmax = fmaxf(pmax, p0[r]);
#pragma unroll
    for (int r = 0; r < 16; ++r) pmax = fmaxf(pmax, p1[r]);
    { auto rr = __builtin_amdgcn_permlane32_swap(__float_as_uint(pmax), __float_as_uint(pmax), false, false);
      pmax = fmaxf(__uint_as_float(rr[0]), __uint_as_float(rr[1])); }
    alpha = 1.f;
    if (__builtin_expect(!__all(pmax <= THRL), 0)) {
        const float d = fmaxf(pmax, 0.f); m_reg += d; alpha = __builtin_amdgcn_exp2f(-d);
#pragma unroll
        for (int r = 0; r < 16; ++r) { p0[r] -= d; p1[r] -= d; }
#pragma unroll
        for (int r = 0; r < 16; ++r) negm[r] = -m_reg;
        asm volatile("" : "+v"(negm));
    }
#pragma unroll
    for (int r = 0; r < 16; ++r) p0[r] = __builtin_amdgcn_exp2f(p0[r]);
}
DI int v_st(int k, int c) { const int kk = (k & ~0xC) | ((k & 4) << 1) | ((k & 8) >> 1); return ((kk >> 3) * 4 + (c >> 5)) * 512 + ((kk & 7) * 32 + (c & 31)) * 2; }
DI int v_rd_base(int lane) { return ((lane & 3) << 3) | (((lane >> 2) & 3) << 6) | (((lane >> 4) & 1) << 5) | (((lane >> 5) & 1) << 8); }
constexpr int v_rd_off(int d0, int ks, int half) { return d0 * 512 + ks * 4096 + half * 2048; }
template <int OFF> DI s16x4 tr_read(int vb) {
    s16x4 r; asm volatile("ds_read_b64_tr_b16 %0, %1 offset:%2" : "=&v"(r) : "v"(vb), "i"(OFF) : "memory"); return r;
}
#define PKLH(L, H) (bf16x8){L[0], L[1], L[2], L[3], H[0], H[1], H[2], H[3]}
template <int TOFF, int D0, int KS> DI bf16x8 frag(int vb) {
    const s16x4 l = tr_read<TOFF + v_rd_off(D0, KS, 0)>(vb), h = tr_read<TOFF + v_rd_off(D0, KS, 1)>(vb);
    asm volatile("s_waitcnt lgkmcnt(0)" ::: "memory");
    return PKLH(l, h);
}
template <int D0> DI void pv_one(f32x16& od, int vb, bf16x8 pa0, bf16x8 pa1, bf16x8 pa2, bf16x8 pa3) {
    const s16x4 l0 = tr_read<v_rd_off(D0, 0, 0)>(vb), h0 = tr_read<v_rd_off(D0, 0, 1)>(vb), l1 = tr_read<v_rd_off(D0, 1, 0)>(vb), h1 = tr_read<v_rd_off(D0, 1, 1)>(vb);
    const s16x4 l2 = tr_read<v_rd_off(D0, 2, 0)>(vb), h2 = tr_read<v_rd_off(D0, 2, 1)>(vb), l3 = tr_read<v_rd_off(D0, 3, 0)>(vb), h3 = tr_read<v_rd_off(D0, 3, 1)>(vb);
    asm volatile("s_waitcnt lgkmcnt(0)" ::: "memory"); SBAR();
    od = __builtin_amdgcn_mfma_f32_32x32x16_bf16(pa0, PKLH(l0, h0), od, 0, 0, 0);
    od = __builtin_amdgcn_mfma_f32_32x32x16_bf16(pa1, PKLH(l1, h1), od, 0, 0, 0);
    od = __builtin_amdgcn_mfma_f32_32x32x16_bf16(pa2, PKLH(l2, h2), od, 0, 0, 0);
    od = __builtin_amdgcn_mfma_f32_32x32x16_bf16(pa3, PKLH(l3, h3), od, 0, 0, 0);
}
DI void pv_d0(f32x16* o, int vb, bf16x8 pa0, bf16x8 pa1, bf16x8 pa2, bf16x8 pa3) {
    pv_one<0>(o[0], vb, pa0, pa1, pa2, pa3); pv_one<1>(o[1], vb, pa0, pa1, pa2, pa3); pv_one<2>(o[2], vb, pa0, pa1, pa2, pa3); pv_one<3>(o[3], vb, pa0, pa1, pa2, pa3);
}

constexpr int LDQ = 1024, LDK = 256, LDO = 1024;
DI void attn_unit(const bf16_t* Qb, const bf16_t* Kc, const bf16_t* Kx, const bf16_t* Vc, const bf16_t* Vx, bf16_t* Ob, char* lds) {
    int tid = threadIdx.x; asm volatile("" : "+v"(tid));
    const int wid = tid >> 6, lane = tid & 63, r32 = lane & 31, hi = lane >> 5;
    char* V_lds = lds; char* K_lds = lds + 2 * SHM_V;
    float* ws = (float*)(lds + 2 * SHM_V + 2 * SHM_K) + wid * 64; float* li_l = ws; float* al_l = ws + 32;
    float m_reg = 0.f, l_reg = 0; f32x16 negm = {}; asm volatile("" : "+v"(negm)); f32x16 o[4] = {}; bf16x8 qr[8];
    const bf16_t* Qw = Qb + (long)(wid * QBLK + r32) * LDQ + hi * 8;
#pragma unroll
    for (int d0 = 0; d0 < 8; ++d0) qr[d0] = *reinterpret_cast<const bf16x8*>(Qw + d0 * 16);
    const int sr = tid >> 4, sc = (tid & 15) * 8, vst0 = v_st(sr, sc), vst1 = v_st(32 + sr, sc);
    const int vb0 = (int)(uintptr_t)V_lds + v_rd_base(lane);
    struct { bf16x8 vs0, vs1, ks0, ks1; } sr_[1];
#define KVP(P, k0) (((k0) < CTX ? P##c + (long)(k0) * LDK : P##x + (long)((k0) - CTX) * LDK))
#define SLOAD(i, k0) do { const bf16_t* vp_ = KVP(V, k0); const bf16_t* kp_ = KVP(K, k0); \
    sr_[i].vs0 = *reinterpret_cast<const bf16x8*>(&vp_[(long)sr * LDK + sc]); sr_[i].vs1 = *reinterpret_cast<const bf16x8*>(&vp_[(long)(32 + sr) * LDK + sc]); \
    sr_[i].ks0 = *reinterpret_cast<const bf16x8*>(&kp_[(long)sr * LDK + sc]); sr_[i].ks1 = *reinterpret_cast<const bf16x8*>(&kp_[(long)(32 + sr) * LDK + sc]); } while (0)
#define SWRITE(b, i) do { *(bf16x8*)(V_lds + (b) * SHM_V + vst0) = sr_[i].vs0;          \
    *(bf16x8*)(V_lds + (b) * SHM_V + vst1) = sr_[i].vs1; int kc = sc * 2;               \
    *(bf16x8*)(K_lds + (b) * SHM_K + KSWZ(sr, kc)) = sr_[i].ks0;                       \
    *(bf16x8*)(K_lds + (b) * SHM_K + KSWZ(32 + sr, kc)) = sr_[i].ks1; } while (0)
#define SWAIT() asm volatile("s_waitcnt vmcnt(0)" ::: "memory")
#define RESC(a) do { if (__any((a) < 1.f)) { if (hi == 0) al_l[r32] = (a); asm volatile("s_waitcnt lgkmcnt(0)" ::: "memory"); \
    _Pragma("unroll") for (int d = 0; d < 4; ++d) _Pragma("unroll") for (int r = 0; r < 16; ++r) o[d][r] *= al_l[crow(r, hi)]; } } while (0)
    f32x16 pA0, pA1, pB0, pB1; float alA, alB; bf16x8 pa0, pa1, pa2, pa3; constexpr int NT = (CTX + SEQ) / KVBLK;
    constexpr int SE = 0, SO = 0;
    SLOAD(SE, 0); asm volatile("s_waitcnt vmcnt(0)" ::: "memory"); SWRITE(0, SE); __syncthreads();
    qkt_m(pA0, pA1, K_lds, qr, negm, r32, hi); partialSM_m(pA0, pA1, m_reg, negm, alA);
    SLOAD(SO, KVBLK);
    SWAIT(); SWRITE(1, SO); __syncthreads();
    for (int j = 1; j + 1 < NT; j += 2) {
        SBAR(); qkt_m(pB0, pB1, K_lds + SHM_K, qr, negm, r32, hi);
        finishSM(pA0, pA1, alA, l_reg, pa0, pa1, pa2, pa3); SBAR();
        SLOAD(SO, (j + 1) * KVBLK); SBAR();
        pv_d0(o, vb0, pa0, pa1, pa2, pa3); partialSM_m(pB0, pB1, m_reg, negm, alB);
        __syncthreads(); SWAIT(); SWRITE(0, SE);
        RESC(alB); __syncthreads();
        SBAR(); qkt_m(pA0, pA1, K_lds, qr, negm, r32, hi);
        finishSM(pB0, pB1, alB, l_reg, pa0, pa1, pa2, pa3); SBAR();
        SLOAD(SE, (j + 2) * KVBLK); SBAR();
        pv_d0(o, vb0 + (int)SHM_V, pa0, pa1, pa2, pa3); partialSM_m(pA0, pA1, m_reg, negm, alA);
        __syncthreads(); SWAIT(); SWRITE(1, SO);
        RESC(alA); __syncthreads();
    }
    SBAR(); qkt_m(pB0, pB1, K_lds + SHM_K, qr, negm, r32, hi);
    finishSM(pA0, pA1, alA, l_reg, pa0, pa1, pa2, pa3); SBAR();
    pv_d0(o, vb0, pa0, pa1, pa2, pa3); partialSM_m(pB0, pB1, m_reg, negm, alB);
    __syncthreads(); RESC(alB);
    finishSM(pB0, pB1, alB, l_reg, pa0, pa1, pa2, pa3); SBAR();
    pv_d0(o, vb0 + (int)SHM_V, pa0, pa1, pa2, pa3);
    if (hi == 0) li_l[r32] = l_reg; asm volatile("s_waitcnt lgkmcnt(0)" ::: "memory");
    float rli[16];
#pragma unroll
    for (int r = 0; r < 16; ++r) rli[r] = __builtin_amdgcn_rcpf(li_l[crow(r, hi)]);
    bf16_t* Ow = Ob + (long)(wid * QBLK) * LDO;
#pragma unroll
    for (int r = 0; r < 16; ++r) { int orow = crow(r, hi);
#pragma unroll
        for (int d0 = 0; d0 < 4; ++d0) Ow[(long)orow * LDO + d0 * 32 + r32] = (bf16_t)f2bf(o[d0][r] * rli[r]); }
    __syncthreads();
#undef KVP
#undef SLOAD
#undef SWRITE
#undef SWAIT
#undef RESC
}

DI void stage_v128(char* dst, const bf16_t* src, int ld, int tid) {
    const int sr = tid >> 4, sc = (tid & 15) * 8;
    bf16x8 v[4];
#pragma unroll
    for (int i = 0; i < 4; ++i) v[i] = *reinterpret_cast<const bf16x8*>(src + (long)(32 * i + sr) * ld + sc);
#pragma unroll
    for (int i = 0; i < 4; ++i) *(bf16x8*)(dst + (i >> 1) * 16384 + v_st((i & 1) * 32 + sr, sc)) = v[i];
}
DI void stage_k128(char* dst, const bf16_t* src, int ld, int tid) {
    const int sr = tid >> 4, sc = (tid & 15) * 8;
    bf16x8 v[4];
#pragma unroll
    for (int i = 0; i < 4; ++i) v[i] = *reinterpret_cast<const bf16x8*>(src + (long)(32 * i + sr) * ld + sc);
#pragma unroll
    for (int i = 0; i < 4; ++i) *(bf16x8*)(dst + (i >> 1) * 16384 + KSWZ((i & 1) * 32 + sr, sc * 2)) = v[i];
}
DI bf16x8 scale8(bf16x8 a, const float* w) {
    const u32x4 u = __builtin_bit_cast(u32x4, a); u32x4 o;
    o.x = pk2(bflo(u.x) * w[0], bfhi(u.x) * w[1]); o.y = pk2(bflo(u.y) * w[2], bfhi(u.y) * w[3]);
    o.z = pk2(bflo(u.z) * w[4], bfhi(u.z) * w[5]); o.w = pk2(bflo(u.w) * w[6], bfhi(u.w) * w[7]);
    return __builtin_bit_cast(bf16x8, o);
}
DI bf16x8 scale1(bf16x8 a, float s) {
    const u32x4 u = __builtin_bit_cast(u32x4, a); u32x4 o;
    o.x = pk2(bflo(u.x) * s, bfhi(u.x) * s); o.y = pk2(bflo(u.y) * s, bfhi(u.y) * s);
    o.z = pk2(bflo(u.z) * s, bfhi(u.z) * s); o.w = pk2(bflo(u.w) * s, bfhi(u.w) * s);
    return __builtin_bit_cast(bf16x8, o);
}
template <int KS> DI void kv_step(f32x16 (&cf)[2], f32x16 (&cb)[2], int vbK, int vbV, const float* wf, const float* wb, int hi) {
    constexpr int TOFF = (KS >> 2) * 16384, K4 = KS & 3;
    const bf16x8 a = frag<TOFF, 0, K4>(vbK);
    const bf16x8 b0 = frag<32768 + TOFF, 0, K4>(vbV), b1 = frag<32768 + TOFF, 1, K4>(vbV);
    float w8[8];
#pragma unroll
    for (int e = 0; e < 8; ++e) w8[e] = wf[16 * KS + 8 * hi + e];
    const bf16x8 af = scale8(a, w8);
#pragma unroll
    for (int e = 0; e < 8; ++e) w8[e] = wb[16 * KS + 8 * hi + e];
    const bf16x8 ab = scale8(a, w8);
    cf[0] = __builtin_amdgcn_mfma_f32_32x32x16_bf16(af, b0, cf[0], 0, 0, 0); cf[1] = __builtin_amdgcn_mfma_f32_32x32x16_bf16(af, b1, cf[1], 0, 0, 0);
    cb[0] = __builtin_amdgcn_mfma_f32_32x32x16_bf16(ab, b0, cb[0], 0, 0, 0); cb[1] = __builtin_amdgcn_mfma_f32_32x32x16_bf16(ab, b1, cb[1], 0, 0, 0);
}
DI void kv_unit(char* lds, const bf16_t* Ksrc, const bf16_t* Vsrc, bf16_t* KVf, bf16_t* KVb, float lgf2, float lgb2) {
    int tid = threadIdx.x; asm volatile("" : "+v"(tid));
    const int wid = tid >> 6, lane = tid & 63, r32 = lane & 31, hi = lane >> 5;
    float* wf = (float*)(lds + 65536); float* wb = wf + 128;
    stage_v128(lds, Ksrc, 1024, tid); stage_v128(lds + 32768, Vsrc, 1024, tid);
    if (tid < 128) wf[tid] = __builtin_amdgcn_exp2f(lgf2 * (float)(127 - tid)); else if (tid < 256) wb[tid - 128] = __builtin_amdgcn_exp2f(lgb2 * (float)(tid - 128));
    __syncthreads();
    const int db = wid & 3, eh = wid >> 2;
    const int vbK = (int)(uintptr_t)lds + v_rd_base(lane) + db * 512, vbV = (int)(uintptr_t)lds + v_rd_base(lane) + eh * 1024;
    f32x16 cf[2] = {}, cb[2] = {};
    kv_step<0>(cf, cb, vbK, vbV, wf, wb, hi); kv_step<1>(cf, cb, vbK, vbV, wf, wb, hi); kv_step<2>(cf, cb, vbK, vbV, wf, wb, hi); kv_step<3>(cf, cb, vbK, vbV, wf, wb, hi);
    kv_step<4>(cf, cb, vbK, vbV, wf, wb, hi); kv_step<5>(cf, cb, vbK, vbV, wf, wb, hi); kv_step<6>(cf, cb, vbK, vbV, wf, wb, hi); kv_step<7>(cf, cb, vbK, vbV, wf, wb, hi);
#pragma unroll
    for (int eb = 0; eb < 2; ++eb)
#pragma unroll
        for (int r = 0; r < 16; ++r) { const int d = 32 * db + crow(r, hi), e = 64 * eh + 32 * eb + r32;
            KVf[d * 128 + e] = (bf16_t)f2bf(cf[eb][r]); KVb[d * 128 + e] = (bf16_t)f2bf(cb[eb][r]); }
    __syncthreads();
}
template <int TOFF, int KS> DI void cross_step(f32x16* o, int vb, bf16x8 a) {
    const bf16x8 b0 = frag<TOFF, 0, KS>(vb), b1 = frag<TOFF, 1, KS>(vb), b2 = frag<TOFF, 2, KS>(vb), b3 = frag<TOFF, 3, KS>(vb);
    o[0] = __builtin_amdgcn_mfma_f32_32x32x16_bf16(a, b0, o[0], 0, 0, 0); o[1] = __builtin_amdgcn_mfma_f32_32x32x16_bf16(a, b1, o[1], 0, 0, 0);
    o[2] = __builtin_amdgcn_mfma_f32_32x32x16_bf16(a, b2, o[2], 0, 0, 0); o[3] = __builtin_amdgcn_mfma_f32_32x32x16_bf16(a, b3, o[3], 0, 0, 0);
}
DI void cross8(f32x16* o, int vb, const bf16x8* qr, float s) {
    cross_step<0, 0>(o, vb, scale1(qr[0], s)); cross_step<0, 1>(o, vb, scale1(qr[1], s)); cross_step<0, 2>(o, vb, scale1(qr[2], s)); cross_step<0, 3>(o, vb, scale1(qr[3], s));
    cross_step<16384, 0>(o, vb, scale1(qr[4], s)); cross_step<16384, 1>(o, vb, scale1(qr[5], s)); cross_step<16384, 2>(o, vb, scale1(qr[6], s)); cross_step<16384, 3>(o, vb, scale1(qr[7], s));
}
DI void ret_unit(char* lds, const bf16_t* Qb, const bf16_t* Kb, const bf16_t* Vb, const bf16_t* Gb, bf16_t* Yb,
                 const bf16_t* Sf, const bf16_t* Sb, float lgf2, float lgb2) {
    int tid = threadIdx.x; asm volatile("" : "+v"(tid));
    const int wid = tid >> 6, lane = tid & 63, r32 = lane & 31, hi = lane >> 5;
    const int cw = wid >> 2, iw = 32 * (wid & 3) + r32;
    bf16x8 qr[8];
    const bf16_t* Qw = Qb + (long)(wid * QBLK + r32) * 1024 + hi * 8;
#pragma unroll
    for (int d0 = 0; d0 < 8; ++d0) qr[d0] = *reinterpret_cast<const bf16x8*>(Qw + d0 * 16);
    stage_k128(lds, Kb, 1024, tid); stage_k128(lds + 32768, Kb + 128 * 1024, 1024, tid);
    stage_v128(lds + 65536, Vb, 1024, tid); stage_v128(lds + 98304, Vb + 128 * 1024, 1024, tid);
    __syncthreads();
    f32x16 o[4] = {};
    const int vbase = (int)(uintptr_t)lds + v_rd_base(lane);
#pragma unroll
    for (int kt = 0; kt < 2; ++kt) {
        f32x16 p0, p1; bf16x8 pa0, pa1, pa2, pa3;
        qkt(p0, p1, lds + cw * 32768 + kt * 16384, qr, r32, hi);
        int iwv = iw - 64 * kt - 4 * hi; asm volatile("" : "+v"(iwv));
#pragma unroll
        for (int r = 0; r < 16; ++r) {
            const int d0 = iwv - ((r & 3) + 8 * (r >> 2)), d1 = d0 - 32;
            const float f0 = (float)d0, f1 = (float)d1;
            float m0 = __builtin_amdgcn_exp2f(d0 > 0 ? lgf2 * f0 : -lgb2 * f0), m1 = __builtin_amdgcn_exp2f(d1 > 0 ? lgf2 * f1 : -lgb2 * f1);
            m0 = d0 == 0 ? 2.f : m0; m1 = d1 == 0 ? 2.f : m1;
            p0[r] *= m0; p1[r] *= m1;
        }
        packP(p0, p1, pa0, pa1, pa2, pa3); SBAR();
        pv_d0(o, vbase + 65536 + cw * 32768 + kt * 16384, pa0, pa1, pa2, pa3);
    }
    __syncthreads();
    stage_v128(lds, Sf, 128, tid); stage_v128(lds + 32768, Sf + 16384, 128, tid);
    stage_v128(lds + 65536, Sb, 128, tid); stage_v128(lds + 98304, Sb + 16384, 128, tid);
    __syncthreads();
    cross8(o, vbase + cw * 32768, qr, __builtin_amdgcn_exp2f(lgf2 * (float)(iw + 1)));
    cross8(o, vbase + 65536 + cw * 32768, qr, __builtin_amdgcn_exp2f(lgb2 * (float)(128 - iw)));
    __syncthreads();
    char* st = lds + wid * 8192;
#pragma unroll
    for (int r = 0; r < 16; ++r) {
        float s = o[0][r] * o[0][r] + o[1][r] * o[1][r] + o[2][r] * o[2][r] + o[3][r] * o[3][r];
        s += __shfl_xor(s, 1); s += __shfl_xor(s, 2); s += __shfl_xor(s, 4); s += __shfl_xor(s, 8); s += __shfl_xor(s, 16);
        const float rstd = rsqrtf(s * (1.f / 128.f) + NEPS);
        const int orow = crow(r, hi);
#pragma unroll
        for (int d0 = 0; d0 < 4; ++d0) *(bf16_t*)(st + orow * 256 + (d0 * 32 + r32) * 2) = (bf16_t)f2bf(o[d0][r] * rstd);
    }
    LDS_WAIT();
    const bf16_t* Gw = Gb + (long)(wid * QBLK) * 1024; bf16_t* Yw = Yb + (long)(wid * QBLK) * 1024;
#pragma unroll 2
    for (int i = 0; i < 8; ++i) {
        const int c = i * 64 + lane, row = c >> 4, col8 = (c & 15) * 8;
        const u32x4 y = *(const u32x4*)(st + row * 256 + col8 * 2); const u32x4 g = *(const u32x4*)(Gw + (long)row * 1024 + col8); u32x4 w;
        w.x = pk2(siluf_(bflo(g.x)) * bflo(y.x), siluf_(bfhi(g.x)) * bfhi(y.x)); w.y = pk2(siluf_(bflo(g.y)) * bflo(y.y), siluf_(bfhi(g.y)) * bfhi(y.y));
        w.z = pk2(siluf_(bflo(g.z)) * bflo(y.z), siluf_(bfhi(g.z)) * bfhi(y.z)); w.w = pk2(siluf_(bflo(g.w)) * bflo(y.w), siluf_(bfhi(g.w)) * bfhi(y.w));
        *(u32x4*)(Yw + (long)row * 1024 + col8) = w;
    }
    __syncthreads();
}
}

DI void transpose_item(const float* W, int N, bf16_t* WT, int K, int k0, int n0, int drow0, float* scr, int lane) {
#pragma unroll 8
    for (int i = 0; i < 32; ++i) { const int kk = 2 * i + (lane >> 5); scr[kk * 33 + (lane & 31)] = W[(size_t)(k0 + kk) * N + n0 + (lane & 31)]; }
    LDS_WAIT();
    const int c = lane & 7;
#pragma unroll
    for (int j = 0; j < 4; ++j) { const int n = (lane >> 3) + 8 * j; const float* s = scr + (8 * c) * 33 + n;
        u32x4 o; o.x = pk2(s[0 * 33], s[1 * 33]); o.y = pk2(s[2 * 33], s[3 * 33]); o.z = pk2(s[4 * 33], s[5 * 33]); o.w = pk2(s[6 * 33], s[7 * 33]);
        *(u32x4*)(WT + (size_t)(drow0 + n) * K + k0 + 8 * c) = o; }
    LDS_WAIT();
}
DI int swiglu_row(int n0) { return n0 < DFF ? 256 * (n0 >> 7) + (n0 & 127) : 256 * ((n0 - DFF) >> 7) + 128 + ((n0 - DFF) & 127); }

DI void norm_rows(const float* srcx, const float* srcc, const float* mod, int ish, int isc, bf16_t* dst, int nrows, int gw, int NGW, int lane) {
    for (int r = gw; r < nrows; r += NGW) {
        const float* src; int bidx;
        if (r < TX) { src = srcx + (size_t)r * DM; bidx = r >> 13; } else { src = srcc + (size_t)(r - TX) * DM; bidx = 4; }
        const float* sh = mod + (size_t)bidx * NMODW + ish * DM; const float* sc = mod + (size_t)bidx * NMODW + isc * DM;
        f32x4 v[8]; float ss = 0.f;
#pragma unroll
        for (int j = 0; j < 8; ++j) { v[j] = ((const f32x4*)src)[lane + 64 * j]; ss += v[j].x * v[j].x + v[j].y * v[j].y + v[j].z * v[j].z + v[j].w * v[j].w; }
        const float rstd = rsqrtf(wave_sum(ss) * (1.f / DM) + NEPS);
#pragma unroll
        for (int j = 0; j < 8; ++j) { const int col = 4 * lane + 256 * j; const f32x4 s4 = *(const f32x4*)(sc + col), h4 = *(const f32x4*)(sh + col);
            const f32x4 o = v[j] * rstd * (s4 + 1.f) + h4; u32x2 w; w.x = pk2(o.x, o.y); w.y = pk2(o.z, o.w);
            *(u32x2*)(dst + (size_t)r * DM + col) = w; }
    }
}


#define LASQ __attribute__((address_space(3)))
#define XB_TMO      128
#define XB_XCNT(j)  (256  + 64 * (j))
#define XB_XSUB(j)  (1280 + 64 * (j))
#define XB_XGEN(j)  (2304 + 64 * (j))
#define XB_TOP      3328
#define XB_TOPGEN   3392
#define XCD_BAR_WORDS 3456
#define XB_SPIN_CAP (1u << 18)
__device__ __forceinline__ unsigned xb_ld(unsigned* p)              { return __hip_atomic_load(p, __ATOMIC_RELAXED, __HIP_MEMORY_SCOPE_AGENT); }
__device__ __forceinline__ unsigned xb_add(unsigned* p, unsigned v) { return __hip_atomic_fetch_add(p, v, __ATOMIC_RELAXED, __HIP_MEMORY_SCOPE_AGENT); }
__device__ __forceinline__ unsigned xb_xcc_id() { return (unsigned)__builtin_amdgcn_s_getreg((3 << 11) | 20) & 0xFu; }
#define XB_SPIN(cond, bar) do { unsigned _sp = 0; while (cond) { __builtin_amdgcn_s_sleep(1); \
    if ((++_sp & 255u) == 0u) { if (xb_ld(&(bar)[XB_TMO])) break; if (_sp > XB_SPIN_CAP) { atomicAdd(&(bar)[XB_TMO], 1u); break; } } } } while (0)
struct XcdBarrier { unsigned* bar; unsigned x; volatile LASQ unsigned* st; };
__device__ __forceinline__ XcdBarrier xcd_barrier_post(unsigned* bar, volatile LASQ unsigned* st) {
    XcdBarrier b; b.bar = bar; b.x = xb_xcc_id(); b.st = st;
    if (threadIdx.x == 0) (void)xb_add(&bar[XB_XCNT(b.x)], 1u);
    return b;
}
__device__ __forceinline__ void xcd_barrier_complete(unsigned* bar, unsigned x, unsigned& nloc, unsigned& nx) {
    const unsigned G = gridDim.x * gridDim.y * gridDim.z;
    unsigned sum, cnt, mine, sp = 0u;
    for (;;) {
        sum = 0u; cnt = 0u; mine = 0u;
#pragma unroll
        for (unsigned j = 0; j < 16; ++j) { const unsigned c = xb_ld(&bar[XB_XCNT(j)]); sum += c; cnt += (c > 0u) ? 1u : 0u; mine = (j == x) ? c : mine; }
        if (sum == G) break;
        __builtin_amdgcn_s_sleep(1);
        if ((++sp & 255u) == 0u) { if (xb_ld(&bar[XB_TMO])) break; if (sp > XB_SPIN_CAP) { atomicAdd(&bar[XB_TMO], 1u); break; } }
    }
    nloc = mine > 0u ? mine : 1u; nx = cnt > 0u ? cnt : 1u;
}
__device__ __forceinline__ void xcd_barrier(const XcdBarrier& b) {
    asm volatile("s_waitcnt vmcnt(0)" ::: "memory");
    __syncthreads();
    if (threadIdx.x == 0) {
        unsigned* bar = b.bar;
        __builtin_amdgcn_s_waitcnt(0);
        unsigned nloc = b.st[0], nx = b.st[1];
        if (nloc == 0u) { xcd_barrier_complete(bar, b.x, nloc, nx); b.st[0] = nloc; b.st[1] = nx; }
        const unsigned old = xb_add(&bar[XB_XSUB(b.x)], 1u);
        const unsigned gen = old / nloc;
        if (old + 1u == (gen + 1u) * nloc) {
            __builtin_amdgcn_fence(__ATOMIC_RELEASE, "agent");
            asm volatile("s_waitcnt vmcnt(0)" ::: "memory");
            const unsigned og = xb_add(&bar[XB_TOP], 1u);
            const unsigned tg = og / nx;
            if (og + 1u == (tg + 1u) * nx) xb_add(&bar[XB_TOPGEN], 1u);
            else XB_SPIN(xb_ld(&bar[XB_TOPGEN]) == tg, bar);
            __builtin_amdgcn_fence(__ATOMIC_ACQUIRE, "agent");
            xb_add(&bar[XB_XGEN(b.x)], 1u);
            asm volatile("s_waitcnt vmcnt(0)" ::: "memory");
        } else {
            XB_SPIN(xb_ld(&bar[XB_XGEN(b.x)]) == gen, bar);
            __builtin_amdgcn_fence(__ATOMIC_ACQUIRE, "agent");
            asm volatile("s_waitcnt vmcnt(0)" ::: "memory");
        }
    }
    __syncthreads();
}

#ifndef PHMASK
#define PHMASK 0xFFFF
#endif
struct Args { const float* in[18]; float* out; unsigned char* ws; };

__global__ void __launch_bounds__(512, 2) mega_fwd(Args a) {
    extern __shared__ __attribute__((aligned(16))) unsigned char lds[];
    cg::grid_group grid = cg::this_grid();
    const int tid = threadIdx.x, lane = tid & 63, wave = __builtin_amdgcn_readfirstlane(tid >> 6);
    const int G = gridDim.x, bid = blockIdx.x;
    const int gw = bid * 8 + wave, NGW = G * 8;
    unsigned char* ws = a.ws;
    const float* x = a.in[0]; const float* cvec = a.in[1]; const float* ctx = a.in[2]; const float* cctx = a.in[3];
    const float* w_ada = a.in[4]; const float* b_ada = a.in[5];
    float* mod = (float*)(ws + WS_MOD);
    bf16_t* W1 = (bf16_t*)(ws + WS_W1); bf16_t* W2 = (bf16_t*)(ws + WS_W2); bf16_t* WIN = (bf16_t*)(ws + WS_WIN); bf16_t* WPA = (bf16_t*)(ws + WS_WPA);
    bf16_t* WPR = (bf16_t*)(ws + WS_WPR); bf16_t* WO = (bf16_t*)(ws + WS_WO); bf16_t* W3 = (bf16_t*)(ws + WS_W3); bf16_t* W4 = (bf16_t*)(ws + WS_W4);
    bf16_t* XN = (bf16_t*)(ws + WS_XN); bf16_t* HID = (bf16_t*)(ws + WS_R);
    PG8_LAS unsigned char* ldsl = (PG8_LAS unsigned char*)lds;

    unsigned* barw = (unsigned*)(ws + WS_MOD + 640 * 1024);
    volatile LASQ unsigned* bst = (volatile LASQ unsigned*)((LASQ unsigned char*)lds + LDS_BYTES - 64);
    if (bid == 0) for (int i = tid; i < XCD_BAR_WORDS; i += 512) barw[i] = 0u;
    if (tid < 2) bst[tid] = 0u;
    __syncthreads();
    if constexpr ((PHMASK >> 0) & 1) {
    if (bid < 72) {
        float* sc = (float*)lds; float* red = (float*)(lds + 40960);
        for (int i = tid; i < 5 * DM; i += 512) { const int c = i / DM, k = i % DM; const float v = c < 4 ? cvec[c * DM + k] : cctx[k]; sc[i] = v / (1.f + __expf(-v)); }
        __syncthreads();
        const int n0 = bid * 256 + lane * 4;
        float acc[5][4];
#pragma unroll
        for (int c = 0; c < 5; ++c)
#pragma unroll
            for (int j = 0; j < 4; ++j) acc[c][j] = 0.f;
#pragma unroll 8
        for (int k = wave * 256; k < wave * 256 + 256; ++k) { const f32x4 w = *(const f32x4*)(w_ada + (size_t)k * NMODW + n0);
#pragma unroll
            for (int c = 0; c < 5; ++c) { const float s = sc[c * DM + k]; acc[c][0] += s * w.x; acc[c][1] += s * w.y; acc[c][2] += s * w.z; acc[c][3] += s * w.w; } }
#pragma unroll
        for (int c = 0; c < 5; ++c)
#pragma unroll
            for (int j = 0; j < 4; ++j) red[(wave * 5 + c) * 256 + lane * 4 + j] = acc[c][j];
        __syncthreads();
        for (int i = tid; i < 5 * 256; i += 512) { const int c = i >> 8, n = i & 255; float s = 0.f;
#pragma unroll
            for (int w = 0; w < 8; ++w) s += red[(w * 5 + c) * 256 + n];
            mod[(size_t)c * NMODW + bid * 256 + n] = s + b_ada[bid * 256 + n]; }
        __syncthreads();
    }
    {
        float* scr = (float*)(lds + wave * 16384);
        constexpr int I1 = 32 * 352, I2 = 88 * 64, IIN = 32 * 304, IPA = 16 * 64, IO = 32 * 64;
        constexpr int NIT = 2 * I1 + 2 * I2 + IIN + 2 * IPA + IO;
        const int nslot = (G > 72) ? 576 + (G - 72) * 16 : NGW;
        const int slot0 = (G > 72 && bid >= 72) ? 576 + ((bid - 72) * 8 + wave) * 2 : gw, nown = (G > 72 && bid >= 72) ? 2 : 1;
        for (int so = 0; so < nown; ++so)
        for (int it = slot0 + so; it < NIT; it += nslot) {
            int r = it;
            if (r < I1) { const int kb = r / 352, nb = r % 352; transpose_item(a.in[6], 2 * DFF, W1, DM, 64 * kb, 32 * nb, swiglu_row(32 * nb), scr, lane); continue; } r -= I1;
            if (r < I2) { const int kb = r / 64, nb = r % 64; transpose_item(a.in[7], DM, W2, DFF, 64 * kb, 32 * nb, 32 * nb, scr, lane); continue; } r -= I2;
            if (r < IIN) { const int kb = r / 304, nb = r % 304; transpose_item(a.in[8], PW, WIN, DM, 64 * kb, 32 * nb, 32 * nb, scr, lane); continue; } r -= IIN;
            if (r < IPA) { const int kb = r / 64, nb = r % 64; transpose_item(a.in[12], DM, WPA, 1024, 64 * kb, 32 * nb, 32 * nb, scr, lane); continue; } r -= IPA;
            if (r < IPA) { const int kb = r / 64, nb = r % 64; transpose_item(a.in[13], DM, WPR, 1024, 64 * kb, 32 * nb, 32 * nb, scr, lane); continue; } r -= IPA;
            if (r < IO) { const int kb = r / 64, nb = r % 64; transpose_item(a.in[14], DM, WO, DM, 64 * kb, 32 * nb, 32 * nb, scr, lane); continue; } r -= IO;
            if (r < I1) { const int kb = r / 352, nb = r % 352; transpose_item(a.in[15], 2 * DFF, W3, DM, 64 * kb, 32 * nb, swiglu_row(32 * nb), scr, lane); continue; } r -= I1;
            { const int kb = r / 64, nb = r % 64; transpose_item(a.in[16], DM, W4, DFF, 64 * kb, 32 * nb, 32 * nb, scr, lane); }
        }
    }
    }
    grid.sync();
    XcdBarrier xb = xcd_barrier_post(barw, bst);

    if constexpr ((PHMASK >> 1) & 1) {
    norm_rows(x, ctx, mod, 0, 1, XN, TT, gw, NGW, lane);
    }
    xcd_barrier(xb);

    if constexpr ((PHMASK >> 2) & 1) {
    { pg8::Gemm g{XN, W1, TT, 2 * DFF, DM}; pg8::StaticOrder S; S.init(TT, 2 * DFF, DM, G, bid); pg8::EpiSwiglu E{HID};
      pg8::gemm_phase<pg8::EpiSwiglu, pg8::StaticOrder>(ldsl, g, S, E); }
    }
    xcd_barrier(xb);

    if constexpr ((PHMASK >> 3) & 1) {
    { pg8::Gemm g{HID, W2, TT, DM, DFF}; pg8::OrderDown1 S; S.init(G, bid); pg8::EpiResid E{x, ctx, a.out, (float*)(ws + WS_PART), mod + 2 * DM, 0.5f};
      pg8::gemm_phase<pg8::EpiResid, pg8::OrderDown1>(ldsl, g, S, E); }
    }
    xcd_barrier(xb);

    if constexpr ((PHMASK >> 4) & 1) {
    norm_rows(a.out, a.out, mod, 3, 4, XN, TX, gw, NGW, lane);
    {
        const float* part = (const float*)(ws + WS_PART); const float* g1 = mod + (size_t)4 * NMODW + 2 * DM; const float* sh = mod + (size_t)4 * NMODW + 3 * DM; const float* sc = mod + (size_t)4 * NMODW + 4 * DM;
        for (int r = NGW - 1 - gw; r < TC; r += NGW) {
            f32x4 v[8]; float ss = 0.f;
#pragma unroll
            for (int j = 0; j < 8; ++j) { const size_t o = (size_t)r * DM + 4 * lane + 256 * j;
                const f32x4 p = (*(const f32x4*)(part + o) + *(const f32x4*)(part + (size_t)TC * DM + o)) + (*(const f32x4*)(part + (size_t)2 * TC * DM + o) + *(const f32x4*)(part + (size_t)3 * TC * DM + o));
                v[j] = *(const f32x4*)(ctx + o) + *(const f32x4*)(g1 + 4 * lane + 256 * j) * 0.5f * p;
                ss += v[j].x * v[j].x + v[j].y * v[j].y + v[j].z * v[j].z + v[j].w * v[j].w; }
            const float rstd = rsqrtf(wave_sum(ss) * (1.f / DM) + NEPS);
#pragma unroll
            for (int j = 0; j < 8; ++j) { const int col = 4 * lane + 256 * j; const f32x4 s4 = *(const f32x4*)(sc + col), h4 = *(const f32x4*)(sh + col);
                const f32x4 o = v[j] * rstd * (s4 + 1.f) + h4; u32x2 w; w.x = pk2(o.x, o.y); w.y = pk2(o.z, o.w);
                *(u32x2*)(XN + (size_t)(TX + r) * DM + col) = w; }
        }
    }
    }
    xcd_barrier(xb);

    if constexpr ((PHMASK >> 5) & 1) {
    { pg8::Gemm g{XN, WIN, TT, PW, DM}; pg8::StaticOrder S; S.init(TT, PW, DM, G, bid); pg8::EpiProj E{ws};
      pg8::gemm_phase<pg8::EpiProj, pg8::StaticOrder>(ldsl, g, S, E); }
    }
    xcd_barrier(xb);

    bf16_t* QA = (bf16_t*)(ws + WS_QA); bf16_t* KA = (bf16_t*)(ws + WS_KA); bf16_t* VA = (bf16_t*)(ws + WS_VA); bf16_t* QR = (bf16_t*)(ws + WS_QR);
    bf16_t* KR = (bf16_t*)(ws + WS_KR); bf16_t* VR = (bf16_t*)(ws + WS_VR); bf16_t* GR = (bf16_t*)(ws + WS_GR); bf16_t* GA = (bf16_t*)(ws + WS_GA); bf16_t* GB = (bf16_t*)(ws + WS_GB);
    bf16_t* KVF = (bf16_t*)(ws + WS_KVF); bf16_t* KVB = (bf16_t*)(ws + WS_KVB);
    const float* dlog = a.in[11];
    constexpr float LOG2E = 1.4426950408889634f;

    if constexpr ((PHMASK >> 6) & 1) {
    {
        const float* qg = a.in[9]; const float* kg = a.in[10];
        f32x2_t* tab = (f32x2_t*)(lds + 69632);
        for (int i = tid; i < 128 * 32; i += 512) { const float invf = exp2f(-(float)(2 * (i & 31)) * (13.287712379549449f / 64.f)); float sn, cs; sincosf((float)(i >> 5) * invf, &sn, &cs); tab[i] = (f32x2_t){cs, sn}; }
        __syncthreads();
        float qgl[16], kgl[4];
#pragma unroll
        for (int i = 0; i < 16; ++i) qgl[i] = qg[(lane & 7) * 16 + i] * (att::SCALE * 1.4426950408889634f);
#pragma unroll
        for (int i = 0; i < 4; ++i) kgl[i] = kg[(lane & 31) * 4 + i];
        const bool qrowpos = (lane & 7) < 4, krowpos = (lane & 31) < 16;
        const int qf0 = ((lane & 7) * 8) & 31, kf0 = ((lane & 31) * 2) & 31;
        for (int r = gw; r < TT; r += NGW) {
            const bool isx = r < TX;
            u32x2* kp = (u32x2*)(KA + (size_t)r * 256) + lane; const u32x2 kw = *kp;
            u32x4* qp = (u32x4*)(QA + (size_t)r * 1024) + 2 * lane; u32x4 q0 = {0, 0, 0, 0}, q1 = {0, 0, 0, 0};
            if (isx) { q0 = qp[0]; q1 = qp[1]; }
            const int t = r & (SEQ - 1), prow = t >> 6, pcol = t & 63;
            {
                float xv[4] = {bflo(kw.x), bfhi(kw.x), bflo(kw.y), bfhi(kw.y)};
                float ss = xv[0] * xv[0] + xv[1] * xv[1] + xv[2] * xv[2] + xv[3] * xv[3];
                ss += __shfl_xor(ss, 1); ss += __shfl_xor(ss, 2); ss += __shfl_xor(ss, 4); ss += __shfl_xor(ss, 8); ss += __shfl_xor(ss, 16);
                const float rstd = rsqrtf(ss * (1.f / 128.f) + NEPS);
                unsigned ow[2];
#pragma unroll
                for (int p = 0; p < 2; ++p) { f32x2_t c = {1.f, 0.f}; if (isx) c = tab[(krowpos ? prow : pcol) * 32 + kf0 + p];
                    const float x0 = xv[2 * p] * rstd * kgl[2 * p], x1 = xv[2 * p + 1] * rstd * kgl[2 * p + 1]; ow[p] = pk2(x0 * c.x - x1 * c.y, x0 * c.y + x1 * c.x); }
                u32x2 o; o.x = ow[0]; o.y = ow[1]; *kp = o;
            }
            if (isx) {
                const unsigned qw[8] = {q0.x, q0.y, q0.z, q0.w, q1.x, q1.y, q1.z, q1.w};
                float ss = 0.f;
#pragma unroll
                for (int p = 0; p < 8; ++p) ss += bflo(qw[p]) * bflo(qw[p]) + bfhi(qw[p]) * bfhi(qw[p]);
                ss += __shfl_xor(ss, 1); ss += __shfl_xor(ss, 2); ss += __shfl_xor(ss, 4);
                const float rstd = rsqrtf(ss * (1.f / 128.f) + NEPS);
                const f32x2_t* tp = tab + (qrowpos ? prow : pcol) * 32 + qf0;
                unsigned ow[8];
#pragma unroll
                for (int p = 0; p < 8; ++p) { const f32x2_t c = tp[p]; const float x0 = bflo(qw[p]) * rstd * qgl[2 * p], x1 = bfhi(qw[p]) * rstd * qgl[2 * p + 1]; ow[p] = pk2(x0 * c.x - x1 * c.y, x0 * c.y + x1 * c.x); }
                u32x4 o0 = {ow[0], ow[1], ow[2], ow[3]}, o1 = {ow[4], ow[5], ow[6], ow[7]}; qp[0] = o0; qp[1] = o1;
            }
        }
        __syncthreads();
        for (int u = bid; u < NB * 8 * NEC; u += G) {
            const int e = u % NEC, bh = u / NEC, b = bh >> 3, h = bh & 7;
            const size_t row0 = e < 2 ? (size_t)TX + b * CTX + e * 128 : (size_t)b * SEQ + (e - 2) * 128;
            const float lf = dlog[h], lb = dlog[8 + h];
            const float lgf2 = -log1pf(expf(-lf)) * LOG2E, lgb2 = -log1pf(expf(-lb)) * LOG2E;
            att::kv_unit((char*)lds, KR + row0 * 1024 + h * 128, VR + row0 * 1024 + h * 128, KVF + ((size_t)bh * NEC + e) * 16384, KVB + ((size_t)bh * NEC + e) * 16384, lgf2, lgb2);
        }
    }
    }
    xcd_barrier(xb);

    if constexpr ((PHMASK >> 7) & 1) {
    for (int task = bid * 512 + tid; task < 64 * 2048; task += G * 512) {
        const int el = (task & 2047) * 8, bhd = task >> 11, dir = bhd & 1, bh = bhd >> 1, h = bh & 7;
        const float lg = dlog[dir * 8 + h]; const float cd = exp2f(128.f * (-log1pf(expf(-lg)) * LOG2E));
        bf16_t* base = (dir ? KVB : KVF) + (size_t)bh * NEC * 16384 + el;
        float S[8];
#pragma unroll
        for (int i = 0; i < 8; ++i) S[i] = 0.f;
        auto ord = [&](int q) { return dir ? (q == 0 ? 1 : q == 1 ? 0 : NEC + 1 - q) : q; };
        for (int s0 = 0; s0 < NEC; s0 += 6) {
            u32x4 cv[6];
#pragma unroll
            for (int i = 0; i < 6; ++i) cv[i] = *(const u32x4*)(base + (size_t)ord(s0 + i) * 16384);
#pragma unroll
            for (int i = 0; i < 6; ++i) {
                const u32x4 cur = cv[i];
                u32x4 o; o.x = pk2(S[0], S[1]); o.y = pk2(S[2], S[3]); o.z = pk2(S[4], S[5]); o.w = pk2(S[6], S[7]);
                *(u32x4*)(base + (size_t)ord(s0 + i) * 16384) = o;
                S[0] = cd * S[0] + bflo(cur.x); S[1] = cd * S[1] + bfhi(cur.x); S[2] = cd * S[2] + bflo(cur.y); S[3] = cd * S[3] + bfhi(cur.y);
                S[4] = cd * S[4] + bflo(cur.z); S[5] = cd * S[5] + bfhi(cur.z); S[6] = cd * S[6] + bflo(cur.w); S[7] = cd * S[7] + bfhi(cur.w);
            }
        }
    }
    }
    xcd_barrier(xb);

    if constexpr ((PHMASK >> 8) & 1) {
#pragma unroll 1
    for (int pass = 0; pass < 2; ++pass) {
    const bool do_ret = (pass == 0) != (((bid >> 3) & 1) != 0);
    if (do_ret)
    for (int u = bid; u < NB * 8 * 32; u += G) {
        const int blk = u & 31, bh = u >> 5, b = bh >> 3, h = bh & 7;
        const size_t row0 = (size_t)b * SEQ + blk * 256;
        const float lf = dlog[h], lb = dlog[8 + h];
        const float lgf2 = -log1pf(expf(-lf)) * LOG2E, lgb2 = -log1pf(expf(-lb)) * LOG2E;
        const size_t so = ((size_t)bh * NEC + 2 + 2 * blk) * 16384;
        att::ret_unit((char*)lds, QR + row0 * 1024 + h * 128, KR + row0 * 1024 + h * 128, VR + row0 * 1024 + h * 128, GR + row0 * 1024 + h * 128, QR + row0 * 1024 + h * 128,
                      KVF + so, KVB + so, lgf2, lgb2);
    }
    else
    for (int u = bid; u < NB * 8 * 32; u += G) {
        const int xc = u & 7, rest = u >> 3, g = rest >> 5, qb = rest & 31, b = xc >> 1, kvh = xc & 1, hq = kvh * 4 + g;
        const size_t qrow = (size_t)b * SEQ + qb * 256;
        att::attn_unit(QA + qrow * 1024 + hq * 128, KA + ((size_t)TX + b * CTX) * 256 + kvh * 128, KA + (size_t)b * SEQ * 256 + kvh * 128,
                       VA + ((size_t)TX + b * CTX) * 256 + kvh * 128, VA + (size_t)b * SEQ * 256 + kvh * 128, QA + qrow * 1024 + hq * 128, (char*)lds);
    }
    }
    }
    xcd_barrier(xb);

    if constexpr ((PHMASK >> 9) & 1) {
    { pg8::Gemm g{QA, WPA, TX, DM, 1024}; pg8::StaticOrder S; S.init(TX, DM, 1024, G, bid); pg8::EpiMerge<0> E{GA, GB};
      pg8::gemm_phase<pg8::EpiMerge<0>, pg8::StaticOrder>(ldsl, g, S, E); }
    { pg8::Gemm g{QR, WPR, TX, DM, 1024}; pg8::StaticOrder S; S.init(TX, DM, 1024, G, bid); pg8::EpiMerge<1> E{GA, GB};
      pg8::gemm_phase<pg8::EpiMerge<1>, pg8::StaticOrder>(ldsl, g, S, E); }
    }
    xcd_barrier(xb);

    if constexpr ((PHMASK >> 10) & 1) {
    { pg8::Gemm g{GA, WO, TX, DM, DM}; pg8::StaticOrder S; S.init(TX, DM, DM, G, bid); pg8::EpiResid E{a.out, a.out, a.out, a.out, mod + 5 * DM, 1.0f};
      pg8::gemm_phase<pg8::EpiResid, pg8::StaticOrder>(ldsl, g, S, E); }
    }
    xcd_barrier(xb);

    if constexpr ((PHMASK >> 11) & 1) {
    norm_rows(a.out, a.out, mod, 6, 7, XN, TX, gw, NGW, lane);
    }
    xcd_barrier(xb);

    if constexpr ((PHMASK >> 12) & 1) {
    { pg8::Gemm g{XN, W3, TX, 2 * DFF, DM}; pg8::StaticOrder S; S.init(TX, 2 * DFF, DM, G, bid); pg8::EpiSwiglu E{HID};
      pg8::gemm_phase<pg8::EpiSwiglu, pg8::StaticOrder>(ldsl, g, S, E); }
    }
    xcd_barrier(xb);

    if constexpr ((PHMASK >> 13) & 1) {
    { pg8::Gemm g{HID, W4, TX, DM, DFF}; pg8::StaticOrder S; S.init(TX, DM, DFF, G, bid); pg8::EpiResid E{a.out, a.out, a.out, a.out, mod + 8 * DM, 0.5f};
      pg8::gemm_phase<pg8::EpiResid, pg8::StaticOrder>(ldsl, g, S, E); }
    }
    xcd_barrier(xb);

    if constexpr ((PHMASK >> 14) & 1) {
    {
        const float* fn = a.in[17];
        for (int r = gw; r < TX; r += NGW) {
            float* row = a.out + (size_t)r * DM; f32x4 v[8]; float ss = 0.f;
#pragma unroll
            for (int j = 0; j < 8; ++j) { v[j] = ((const f32x4*)row)[lane + 64 * j]; ss += v[j].x * v[j].x + v[j].y * v[j].y + v[j].z * v[j].z + v[j].w * v[j].w; }
            const float rstd = rsqrtf(wave_sum(ss) * (1.f / DM) + NEPS);
#pragma unroll
            for (int j = 0; j < 8; ++j) { const f32x4 f4 = ((const f32x4*)fn)[lane + 64 * j]; ((f32x4*)row)[lane + 64 * j] = v[j] * rstd * f4; }
        }
    }
    }
}

extern "C" void kernel_launch(void* const* d_in, const int* in_sizes, int n_in, void* d_out, int out_size, void* d_ws, size_t ws_size, hipStream_t stream) {
    static int grid = 0;
    if (grid == 0) {
        int dev = 0, cus = 0, per_cu = 0;
        (void)hipGetDevice(&dev);
        (void)hipDeviceGetAttribute(&cus, hipDeviceAttributeMultiprocessorCount, dev);
        if (hipFuncSetAttribute((const void*)mega_fwd, hipFuncAttributeMaxDynamicSharedMemorySize, LDS_BYTES) != hipSuccess) fprintf(stderr, "kernel_launch: hipFuncSetAttribute failed\n");
        (void)hipOccupancyMaxActiveBlocksPerMultiprocessor(&per_cu, (const void*)mega_fwd, 512, LDS_BYTES);
        if (ws_size < WS_END || n_in != 18) { fprintf(stderr, "kernel_launch: workspace %zu < %zu or n_in %d != 18\n", ws_size, (size_t)WS_END, n_in); grid = -1; return; }
        if (per_cu < 1) fprintf(stderr, "kernel_launch: occupancy query says %d blocks per CU\n", per_cu);
        grid = cus > 0 ? cus : 256;
    }
    if (grid < 0) return;
    Args a{};
    for (int i = 0; i < 18; ++i) a.in[i] = (const float*)d_in[i];
    a.out = (float*)d_out; a.ws = (unsigned char*)d_ws;
    void* args[] = {&a};
    hipError_t e = hipLaunchCooperativeKernel((const void*)mega_fwd, dim3(grid), dim3(512), args, LDS_BYTES, stream);
    if (e != hipSuccess) fprintf(stderr, "kernel_launch: cooperative launch failed: %s (grid %d)\n", hipGetErrorString(e), grid);
}
```
